# Optimizing an MI355X kernel written in HIP

```python
import math
import jax, jax.numpy as jnp
from jax import lax
import numpy as np

D_MODEL = 1024
BATCH = 2
SEQ = 8192
DEPTH = 4

N_MIXERS = 4
HEAD_DIM = 64
N_HEADS = D_MODEL // HEAD_DIM
ROT_DIM = HEAD_DIM // 4
ROPE_THETA = 500000.0
Q_BLOCK = 128
DIL_CONFIGS = ((128, 1), (512, 4), (2048, 16))
N_HEADS_DIL = 8
DIL_GROUP_WIDTH = N_HEADS_DIL * HEAD_DIM
DIL_IN_WIDTH = len(DIL_CONFIGS) * 3 * DIL_GROUP_WIDTH
IDX_HEADS = 8
IDX_DIM = 64
TOPK_TOKENS = 256
DSA_IN_WIDTH = 3 * D_MODEL + IDX_HEADS * IDX_DIM + IDX_DIM + IDX_HEADS
MOBA_BLOCK = 256
MOBA_TOPK = 3
MOBA_Q_CHUNK = 32
D_FF = 4 * D_MODEL
PLE_DIM = 256
EPS = 1e-6

kernel_name = 'hybrid_sb_dilated_dsa_moba_trunk'


def _n_layers_of(mixer):
    return len(range(mixer, DEPTH, N_MIXERS))


def rms_norm(x, g):
    x32 = x.astype(jnp.float32)
    y = x32 * lax.rsqrt(jnp.mean(x32 * x32, axis=-1, keepdims=True) + EPS)
    return (y * g.astype(jnp.float32)).astype(x.dtype)


def rope_tables(positions):
    inv_freq = ROPE_THETA ** (-jnp.arange(0, ROT_DIM, 2, dtype=jnp.float32) / ROT_DIM)
    ang = positions.astype(jnp.float32)[..., None] * inv_freq
    return jnp.cos(ang)[:, :, None, :], jnp.sin(ang)[:, :, None, :]


def apply_partial_rope(t, cos, sin):
    half = ROT_DIM // 2
    t1 = t[..., :half].astype(jnp.float32)
    t2 = t[..., half:ROT_DIM].astype(jnp.float32)
    rot = jnp.concatenate([t1 * cos - t2 * sin, t2 * cos + t1 * sin], axis=-1).astype(t.dtype)
    return jnp.concatenate([rot, t[..., ROT_DIM:]], axis=-1)


def stick_breaking_attention(x, w_in, w_out):
    B, S, _ = x.shape
    q, k, v = jnp.split(x @ w_in, 3, axis=-1)
    q = q.reshape(B, S, N_HEADS, HEAD_DIM)
    k = k.reshape(B, S, N_HEADS, HEAD_DIM)
    v = v.reshape(B, S, N_HEADS, HEAD_DIM)
    scale = HEAD_DIM ** -0.5
    outs = []
    for blk in range(S // Q_BLOCK):
        t0 = blk * Q_BLOCK
        L = t0 + Q_BLOCK
        z = jnp.einsum('bqhd,bkhd->bhqk', q[:, t0:L], k[:, :L]).astype(jnp.float32) * scale
        t_idx = t0 + jnp.arange(Q_BLOCK)[:, None]
        s_idx = jnp.arange(L)[None, :]
        past = s_idx < t_idx
        log_fail = jnp.where(past, jax.nn.log_sigmoid(-z), 0.0)
        later = lax.cumsum(log_fail, axis=3, reverse=True) - log_fail
        a = jnp.where(past, jnp.exp(jax.nn.log_sigmoid(z) + later), 0.0)
        outs.append(jnp.einsum('bhqk,bkhd->bqhd', a.astype(v.dtype), v[:, :L]))
    o = jnp.concatenate(outs, axis=1).reshape(B, S, N_HEADS * HEAD_DIM)
    return o @ w_out


def banded_attention(q, k, v, n_back):
    N, L, H, Dh = q.shape
    nb = L // Q_BLOCK
    qb = q.reshape(N, nb, Q_BLOCK, H, Dh)
    kb = k.reshape(N, nb, Q_BLOCK, H, Dh)
    vb = v.reshape(N, nb, Q_BLOCK, H, Dh)
    zero = jnp.zeros_like(kb[:, :1])
    k2 = jnp.concatenate([jnp.concatenate([zero, kb[:, :-1]], axis=1), kb], axis=2)
    v2 = jnp.concatenate([jnp.concatenate([zero, vb[:, :-1]], axis=1), vb], axis=2)
    s = jnp.einsum('nbqhd,nbkhd->nbhqk', qb, k2).astype(jnp.float32) * (Dh ** -0.5)
    dist = Q_BLOCK + jnp.arange(Q_BLOCK)[:, None] - jnp.arange(2 * Q_BLOCK)[None, :]
    band = (dist >= 0) & (dist <= n_back)
    first_pad = (jnp.arange(nb) == 0)[:, None, None] & (jnp.arange(2 * Q_BLOCK) < Q_BLOCK)[None, None, :]
    mask = band[None] & ~first_pad
    s = jnp.where(mask[None, :, None], s, -jnp.inf)
    lse = jax.nn.logsumexp(s, axis=-1)
    prob = jnp.exp(s - lse[..., None])
    o = jnp.einsum('nbhqk,nbkhd->nbqhd', prob.astype(v.dtype), v2)
    return o.reshape(N, L, H, Dh), lse.transpose(0, 1, 3, 2).reshape(N, L, H)


def dilated_attention(x, w_in, w_out, cos, sin):
    B, S, _ = x.shape
    H = N_HEADS_DIL
    G = len(DIL_CONFIGS)
    proj = (x @ w_in).reshape(B, S, G, 3, H, HEAD_DIM)
    outs, lses = [], []
    for g, (window, dil) in enumerate(DIL_CONFIGS):
        q = apply_partial_rope(proj[:, :, g, 0], cos, sin)
        k = apply_partial_rope(proj[:, :, g, 1], cos, sin)
        v = proj[:, :, g, 2]
        L = S // dil
        Lp = -(-L // Q_BLOCK) * Q_BLOCK

        def strided(t):
            t = t.reshape(B, L, dil, H, HEAD_DIM).transpose(0, 2, 1, 3, 4).reshape(B * dil, L, H, HEAD_DIM)
            return jnp.pad(t, ((0, 0), (0, Lp - L), (0, 0), (0, 0)))

        o, lse = banded_attention(strided(q), strided(k), strided(v), window // dil)
        o = o[:, :L].reshape(B, dil, L, H, HEAD_DIM).transpose(0, 2, 1, 3, 4).reshape(B, S, H, HEAD_DIM)
        lse = lse[:, :L].reshape(B, dil, L, H).transpose(0, 2, 1, 3).reshape(B, S, H)
        outs.append(o)
        lses.append(lse)
    alpha = jax.nn.softmax(jnp.stack(lses, axis=0), axis=0)
    o = jnp.einsum('gbsh,gbshd->bshd', alpha, jnp.stack(outs, axis=0).astype(jnp.float32)).astype(x.dtype)
    return o.reshape(B, S, H * HEAD_DIM) @ w_out


def dsa_attention(x, w_in, w_out, cos, sin):
    B, S, _ = x.shape
    D = N_HEADS * HEAD_DIM
    cuts = [D, 2 * D, 3 * D, 3 * D + IDX_HEADS * IDX_DIM, 3 * D + IDX_HEADS * IDX_DIM + IDX_DIM]
    q, k, v, qi, ki, wi = jnp.split(x @ w_in, cuts, axis=-1)
    q = apply_partial_rope(q.reshape(B, S, N_HEADS, HEAD_DIM), cos, sin)
    k = apply_partial_rope(k.reshape(B, S, N_HEADS, HEAD_DIM), cos, sin)
    v = v.reshape(B, S, N_HEADS, HEAD_DIM)
    qi = apply_partial_rope(qi.reshape(B, S, IDX_HEADS, IDX_DIM), cos, sin)
    ki = apply_partial_rope(ki.reshape(B, S, 1, IDX_DIM), cos, sin)[:, :, 0]
    wi = wi.astype(jnp.float32) * (IDX_HEADS ** -0.5)
    topk = min(TOPK_TOKENS, S // 4)
    scale = HEAD_DIM ** -0.5
    key_pos = jnp.arange(S)

    def block(bi):
        t0 = bi * Q_BLOCK
        t_pos = t0 + jnp.arange(Q_BLOCK)
        qb = lax.dynamic_slice_in_dim(q, t0, Q_BLOCK, axis=1)
        qib = lax.dynamic_slice_in_dim(qi, t0, Q_BLOCK, axis=1)
        wib = lax.dynamic_slice_in_dim(wi, t0, Q_BLOCK, axis=1)
        rel = jax.nn.relu(jnp.einsum('bqhd,bkd->bqhk', qib, ki).astype(jnp.float32))
        score = jnp.einsum('bqh,bqhk->bqk', wib, rel)
        causal = key_pos[None, :] <= t_pos[:, None]
        score = jnp.where(causal[None], score, -jnp.inf)
        _, idx = lax.top_k(score, topk)
        valid = idx <= t_pos[None, :, None]
        k_sel = jax.vmap(lambda kk, ii: kk[ii])(k, idx)
        v_sel = jax.vmap(lambda vv, ii: vv[ii])(v, idx)
        s = jnp.einsum('bqhd,bqkhd->bqhk', qb, k_sel).astype(jnp.float32) * scale
        s = jnp.where(valid[:, :, None, :], s, -jnp.inf)
        prob = jax.nn.softmax(s, axis=-1)
        return jnp.einsum('bqhk,bqkhd->bqhd', prob.astype(v.dtype), v_sel)

    o = lax.map(block, jnp.arange(S // Q_BLOCK))
    o = o.transpose(1, 0, 2, 3, 4).reshape(B, S, D)
    return o @ w_out


def moba_attention(x, w_in, w_out, cos, sin):
    B, S, _ = x.shape
    H = N_HEADS
    q, k, v = jnp.split(x @ w_in, 3, axis=-1)
    q = apply_partial_rope(q.reshape(B, S, H, HEAD_DIM), cos, sin)
    k = apply_partial_rope(k.reshape(B, S, H, HEAD_DIM), cos, sin)
    v = v.reshape(B, S, H, HEAD_DIM)
    nb = -(-S // MOBA_BLOCK)
    Sp = nb * MOBA_BLOCK
    pad = ((0, 0), (0, Sp - S), (0, 0), (0, 0))
    kb = jnp.pad(k, pad).reshape(B, nb, MOBA_BLOCK, H, HEAD_DIM).transpose(0, 3, 1, 2, 4)
    vb = jnp.pad(v, pad).reshape(B, nb, MOBA_BLOCK, H, HEAD_DIM).transpose(0, 3, 1, 2, 4)
    k_mean = jnp.mean(kb.astype(jnp.float32), axis=3)
    topk = min(MOBA_TOPK, nb - 1)
    scale = HEAD_DIM ** -0.5
    b_ix = jnp.arange(B)[:, None, None, None]
    h_ix = jnp.arange(H)[None, None, :, None]

    def chunk(ci):
        t0 = ci * MOBA_Q_CHUNK
        t_pos = t0 + jnp.arange(MOBA_Q_CHUNK)
        cur = t0 // MOBA_BLOCK
        qc = lax.dynamic_slice_in_dim(q, t0, MOBA_Q_CHUNK, axis=1)
        k_own = lax.dynamic_index_in_dim(kb, cur, axis=2, keepdims=False)
        v_own = lax.dynamic_index_in_dim(vb, cur, axis=2, keepdims=False)
        own_pos = cur * MOBA_BLOCK + jnp.arange(MOBA_BLOCK)
        s_own = jnp.einsum('bqhd,bhkd->bqhk', qc, k_own).astype(jnp.float32) * scale
        s_own = jnp.where((own_pos[None, :] <= t_pos[:, None])[None, :, None, :], s_own, -jnp.inf)
        if topk == 0:
            prob = jax.nn.softmax(s_own, axis=-1)
            return jnp.einsum('bqhk,bhkd->bqhd', prob.astype(v.dtype), v_own)
        gate = jnp.einsum('bqhd,bhnd->bqhn', qc.astype(jnp.float32), k_mean)
        gate = jnp.where(jnp.arange(nb) < cur, gate, -jnp.inf)
        _, sel = lax.top_k(gate, topk)
        valid = sel < cur
        k_sel = kb[b_ix, h_ix, sel]
        v_sel = vb[b_ix, h_ix, sel]
        s_sel = jnp.einsum('bqhd,bqhjkd->bqhjk', qc, k_sel).astype(jnp.float32) * scale
        s_sel = jnp.where(valid[..., None], s_sel, -jnp.inf).reshape(B, MOBA_Q_CHUNK, H, topk * MOBA_BLOCK)
        prob = jax.nn.softmax(jnp.concatenate([s_sel, s_own], axis=-1), axis=-1).astype(v.dtype)
        p_sel = prob[..., :topk * MOBA_BLOCK].reshape(B, MOBA_Q_CHUNK, H, topk, MOBA_BLOCK)
        p_own = prob[..., topk * MOBA_BLOCK:]
        return (jnp.einsum('bqhjk,bqhjkd->bqhd', p_sel, v_sel)
                + jnp.einsum('bqhk,bhkd->bqhd', p_own, v_own))

    o = lax.map(chunk, jnp.arange(S // MOBA_Q_CHUNK))
    o = o.transpose(1, 0, 2, 3, 4).reshape(B, S, H * HEAD_DIM)
    return o @ w_out


def setup_inputs(seed: int = 0) -> dict:
    key = jax.random.key(seed)
    ks = iter(jax.random.split(key, 32))

    def dense(shape, fan_in):
        return jax.random.normal(next(ks), shape, jnp.float32) * (fan_in ** -0.5)

    def gain(shape):
        return 1.0 + 0.05 * jax.random.normal(next(ks), shape, jnp.float32)

    nA, nB, nC, nD = (_n_layers_of(m) for m in range(N_MIXERS))
    x = jax.random.normal(next(ks), (BATCH, SEQ, D_MODEL), jnp.float32)
    p = jax.random.normal(next(ks), (DEPTH, BATCH, SEQ, PLE_DIM), jnp.float32)
    offsets = jax.random.randint(next(ks), (BATCH, 1), 0, 4096, dtype=jnp.int32)
    positions = offsets + jnp.arange(SEQ, dtype=jnp.int32)[None, :]
    return {
        'x': x,
        'p': p,
        'positions': positions,
        'w_in_sb': dense((nA, D_MODEL, 3 * D_MODEL), D_MODEL),
        'w_out_sb': dense((nA, D_MODEL, D_MODEL), D_MODEL),
        'w_in_dil': dense((nB, D_MODEL, DIL_IN_WIDTH), D_MODEL),
        'w_out_dil': dense((nB, DIL_GROUP_WIDTH, D_MODEL), DIL_GROUP_WIDTH),
        'w_in_dsa': dense((nC, D_MODEL, DSA_IN_WIDTH), D_MODEL),
        'w_out_dsa': dense((nC, D_MODEL, D_MODEL), D_MODEL),
        'w_in_moba': dense((nD, D_MODEL, 3 * D_MODEL), D_MODEL),
        'w_out_moba': dense((nD, D_MODEL, D_MODEL), D_MODEL),
        'g_mix_pre': gain((DEPTH, D_MODEL)),
        'g_mix_post': gain((DEPTH, D_MODEL)),
        'g_ffn_pre': gain((DEPTH, D_MODEL)),
        'g_ffn_post': gain((DEPTH, D_MODEL)),
        'w_ff_in': dense((DEPTH, D_MODEL, D_FF), D_MODEL),
        'w_ff_out': dense((DEPTH, D_FF, D_MODEL), D_FF),
        'g_ple': gain((DEPTH, D_MODEL)),
        'w_ple_gate': dense((DEPTH, D_MODEL, D_MODEL), D_MODEL),
        'w_ple': dense((DEPTH, PLE_DIM, D_MODEL), PLE_DIM),
    }


def reference(x, p, positions, w_in_sb, w_out_sb, w_in_dil, w_out_dil, w_in_dsa, w_out_dsa,
              w_in_moba, w_out_moba, g_mix_pre, g_mix_post, g_ffn_pre, g_ffn_post,
              w_ff_in, w_ff_out, g_ple, w_ple_gate, w_ple):
    cos, sin = rope_tables(positions)
    h = x
    for i in range(DEPTH):
        mixer, j = i % N_MIXERS, i // N_MIXERS
        u = rms_norm(h, g_mix_pre[i])
        if mixer == 0:
            y = stick_breaking_attention(u, w_in_sb[j], w_out_sb[j])
        elif mixer == 1:
            y = dilated_attention(u, w_in_dil[j], w_out_dil[j], cos, sin)
        elif mixer == 2:
            y = dsa_attention(u, w_in_dsa[j], w_out_dsa[j], cos, sin)
        else:
            y = moba_attention(u, w_in_moba[j], w_out_moba[j], cos, sin)
        h = h + rms_norm(y, g_mix_post[i])
        u = rms_norm(h, g_ffn_pre[i])
        f = jnp.square(jax.nn.relu(u @ w_ff_in[i])) @ w_ff_out[i]
        h = h + rms_norm(f, g_ffn_post[i])
        gate = jax.nn.sigmoid(rms_norm(h, g_ple[i]) @ w_ple_gate[i])
        h = h + (p[i] @ w_ple[i]) * gate
    return h
```

```cpp
#include <hip/hip_runtime.h>
#include <hip/hip_cooperative_groups.h>
#include <cstdio>
#include <cstdint>
namespace pg8 {
#define PG8_LAS __attribute__((address_space(3)))
typedef unsigned short bf16_t;
typedef short bf16x8 __attribute__((ext_vector_type(8)));
typedef float f32x4 __attribute__((ext_vector_type(4)));
typedef unsigned u32x4 __attribute__((ext_vector_type(4)));
constexpr int BM = 256, BK = 64, HALF = 128, HTB = HALF * BK * 2  , STAGE_BYTES = 8 * HTB, NXCD = 8, WGM = 8;

__host__ __device__ __forceinline__ int lds_byte(int r, int c) { const int st = (r >> 4) * 2 + (c >> 5), rr = r & 15, cc = c & 31, ob = rr * 64 + cc * 2; return st * 1024 + (ob ^ (((ob >> 9) & 1) << 5)); }
__host__ __device__ __forceinline__ void stage_rc(int b, int& R, int& C) { const int st = b / 1024, sb = b % 1024, swz = sb ^ (((sb >> 9) & 1) << 5); R = (st >> 1) * 16 + swz / 64; C = (st & 1) * 32 + (swz % 64) / 2; }
__host__ __device__ __forceinline__ int perm32(int rho) { const int n = rho >> 4, i = rho & 15; return 8 * (i >> 2) + 4 * n + (i & 3); }

struct Unit { int pm, pn; };
struct Gemm { const bf16_t* A; const bf16_t* Bt; int M, N, K; };

struct StaticOrder {
    int nM, nN, nwg, G, c;
    __host__ __device__ void init(int M, int N, int G_, int c_) { nM = M / BM; nN = N / BM; nwg = nM * nN; G = G_; c = c_; }
    __host__ __device__ bool next(int i, Unit& u) const {
        const long L = (long)i * G + c; if (L >= nwg) return false;
        int wgid = (int)L; { const int q = nwg / NXCD, r = nwg % NXCD, xcd = wgid % NXCD, off = wgid / NXCD; wgid = (xcd < r ? xcd * (q + 1) : r * (q + 1) + (xcd - r) * q) + off; }
        const int nig = WGM * nN, gid = wgid / nig, fm = gid * WGM, gsz = (nM - fm) < WGM ? (nM - fm) : WGM;
        u.pm = fm + ((wgid % nig) % gsz); u.pn = (wgid % nig) / gsz; return true;
    }
    __device__ __forceinline__ void a_ready(const Unit&) const {}
    __device__ __forceinline__ void done(const Unit&) const {}
};

__device__ __forceinline__ unsigned cvt_pk_bf16(float lo, float hi) { unsigned r; asm volatile("v_cvt_pk_bf16_f32 %0, %1, %2" : "=v"(r) : "v"(lo), "v"(hi)); return r; }
typedef float f32x2 __attribute__((ext_vector_type(2)));
__device__ __forceinline__ f32x2 gelu_pk(f32x2 v) {
    const f32x2 av = __builtin_elementwise_abs(v), d = av * 0.2316418882f + 1.0f;
    f32x2 t; t.x = __builtin_amdgcn_rcpf(d.x); t.y = __builtin_amdgcn_rcpf(d.y);
    f32x2 q = t * 0.5307027145f + (-0.7265760135f); q = q * t + 0.7107068705f; q = q * t + (-0.142248368f); q = q * t + 0.127414796f; q = q * t;
    const f32x2 s = (v * v) * (-0.72134752044f);
    f32x2 e; e.x = __builtin_amdgcn_exp2f(s.x); e.y = __builtin_amdgcn_exp2f(s.y);
    const f32x2 m = v * (q * e), r = v - m;
    f32x2 o; o.x = v.x < 0.f ? m.x : r.x; o.y = v.y < 0.f ? m.y : r.y; return o;
}

template <int ACT  > struct EpiBf16 {
    static constexpr bool PERM = true, AFTER_DRAIN = false; static_assert(ACT == 0 || ACT == 1, "EpiBf16: ACT is 0 (none) or 1 (gelu_pk)");
    bf16_t* O; int ldc; const float* bias; int split_cols; size_t split_stride; float scale0;
    __device__ __forceinline__ void operator()(const f32x4 (&acc)[2][2][4][2], const Unit& u, int wr, int wc, int fr, int fq) const {
        const int row0 = u.pm * BM + wr * 64 + fr; int colt = u.pn * BM; bf16_t* base = O;
        float sc = 1.f; if (split_cols) { const int t = colt / split_cols; base += (size_t)t * split_stride; colt -= t * split_cols; if (t == 0) sc = scale0; }
        const int col0 = colt + wc * 32 + 8 * fq, bcol0 = u.pn * BM + wc * 32 + 8 * fq;
        f32x4 bv[2][2];
#pragma unroll
        for (int bj = 0; bj < 2; ++bj)
#pragma unroll
            for (int n = 0; n < 2; ++n) bv[bj][n] = bias ? *(const f32x4*)(bias + bcol0 + bj * HALF + 4 * n) : (f32x4){0.f, 0.f, 0.f, 0.f};
#pragma unroll
        for (int ai = 0; ai < 2; ++ai)
#pragma unroll
            for (int m = 0; m < 4; ++m) { bf16_t* rowp = base + (size_t)(row0 + ai * HALF + m * 16) * ldc + col0;
#pragma unroll
                for (int bj = 0; bj < 2; ++bj) { f32x4 v0 = acc[ai][bj][m][0] + bv[bj][0], v1 = acc[ai][bj][m][1] + bv[bj][1];
                    if (ACT == 1) { f32x2 a = gelu_pk((f32x2){v0[0], v0[1]}), b = gelu_pk((f32x2){v0[2], v0[3]}), c = gelu_pk((f32x2){v1[0], v1[1]}), d = gelu_pk((f32x2){v1[2], v1[3]});
                        v0 = (f32x4){a.x, a.y, b.x, b.y}; v1 = (f32x4){c.x, c.y, d.x, d.y}; }
                    v0 = v0 * sc; v1 = v1 * sc; u32x4 w; w.x = cvt_pk_bf16(v0[0], v0[1]); w.y = cvt_pk_bf16(v0[2], v0[3]); w.z = cvt_pk_bf16(v1[0], v1[1]); w.w = cvt_pk_bf16(v1[2], v1[3]);
                    *(u32x4*)(rowp + bj * HALF) = w; } }
    }
};
template <class Epi, class Sched, bool ALIGN_EPI = false, bool SP2 = false>
__device__ __forceinline__ void gemm_phase(PG8_LAS unsigned char* lds, const Gemm g, const Sched& S, const Epi& E) {
    int tid_ = threadIdx.x; asm volatile("" : "+v"(tid_));
    const int tid = tid_, wid = __builtin_amdgcn_readfirstlane(tid >> 6), lane = tid & 63, wr = wid >> 2, wc = wid & 3, fr = lane & 15, fq = lane >> 4;
    const int K = g.K, nt = K / BK;
    unsigned voffA[2], voffB[2];
#pragma unroll
    for (int i = 0; i < 2; ++i) { int R, C; stage_rc(tid * 16 + i * 8192, R, C); const int Rb = Epi::PERM ? ((R & ~31) + perm32(R & 31)) : R;
        voffA[i] = (unsigned)(R * K + C) * 2u; voffB[i] = (unsigned)(Rb * K + C) * 2u; }
    const size_t kstep = (size_t)(BK * 2);
    const size_t hstep = (size_t)HALF * K * 2;
    const size_t tstep = 2 * hstep;
    const unsigned ldsw = (unsigned)wid * 1024u;
    const int aoff = lds_byte(wr * 64 + fr, fq * 8), boff = lds_byte(wc * 32 + fr, fq * 8);
#define PG8_SA(b, h) (((b) * 2 + (h)) * HTB)
#define PG8_SB(b, h) ((4 + (b) * 2 + (h)) * HTB)
#define PG8_STAGE(bufoff, gbase, voff) do { _Pragma("unroll") for (int _i = 0; _i < 2; ++_i) \
        __builtin_amdgcn_global_load_lds((const unsigned*)((const char*)(gbase) + (voff)[_i]), (PG8_LAS unsigned*)(lds + (bufoff) + ldsw + _i * 8192), 16, 0, 0); } while (0)
#define PG8_LDA(dst, b, h) do { _Pragma("unroll") for (int m = 0; m < 4; ++m) _Pragma("unroll") for (int k = 0; k < 2; ++k) dst[m][k] = *(const PG8_LAS bf16x8*)(lds + PG8_SA(b, h) + aoff + m * 2048 + k * 1024); } while (0)
#define PG8_LDB(dst, b, h) do { _Pragma("unroll") for (int n = 0; n < 2; ++n) _Pragma("unroll") for (int k = 0; k < 2; ++k) dst[n][k] = *(const PG8_LAS bf16x8*)(lds + PG8_SB(b, h) + boff + n * 2048 + k * 1024); } while (0)
#define PG8_MMA(ai, bj, At, Bt) do { __builtin_amdgcn_s_setprio(1); _Pragma("unroll") for (int m = 0; m < 4; ++m) _Pragma("unroll") for (int n = 0; n < 2; ++n) _Pragma("unroll") for (int k = 0; k < 2; ++k) \
        acc[ai][bj][m][n] = __builtin_amdgcn_mfma_f32_16x16x32_bf16(Bt[n][k], At[m][k], acc[ai][bj][m][n], 0, 0, 0); __builtin_amdgcn_s_setprio(0); } while (0)
#define PG8_WAIT_V(n) asm volatile("s_waitcnt vmcnt(" #n ")" ::: "memory")
#define PG8_WAIT_L(n) asm volatile("s_waitcnt lgkmcnt(" #n ")" ::: "memory")
#define PG8_BAR __builtin_amdgcn_s_barrier()
#define PG8_SCHED __builtin_amdgcn_sched_barrier(0)
    Unit cur, nxt; int ui = 0;
    if (!S.next(0, cur)) return;
    f32x4 acc[2][2][4][2];
#pragma unroll
    for (int a = 0; a < 2; ++a)
#pragma unroll
        for (int b = 0; b < 2; ++b)
#pragma unroll
            for (int m = 0; m < 4; ++m)
#pragma unroll
                for (int n = 0; n < 2; ++n) acc[a][b][m][n] = (f32x4){0.f, 0.f, 0.f, 0.f};
    bf16x8 At[4][2], B0[2][2], B1[2][2];
    const char* cA = (const char*)g.A + (size_t)cur.pm * tstep; const char* cB = (const char*)g.Bt + (size_t)cur.pn * tstep;
    S.a_ready(cur);
    if constexpr (SP2) {
        PG8_STAGE(PG8_SB(0, 0), cB, voffB); PG8_STAGE(PG8_SB(0, 1), cB + hstep, voffB); PG8_STAGE(PG8_SA(0, 0), cA, voffA); PG8_STAGE(PG8_SA(0, 1), cA + hstep, voffA);
        if (wr == 1) PG8_BAR;
        PG8_WAIT_V(2); PG8_BAR;
        PG8_STAGE(PG8_SB(1, 0), cB + kstep, voffB); PG8_STAGE(PG8_SA(1, 0), cA + kstep, voffA); PG8_STAGE(PG8_SB(1, 1), cB + hstep + kstep, voffB);
        PG8_WAIT_V(6); PG8_BAR;
    } else {
        PG8_STAGE(PG8_SB(0, 0), cB, voffB); PG8_STAGE(PG8_SA(0, 0), cA, voffA); PG8_STAGE(PG8_SB(0, 1), cB + hstep, voffB); PG8_STAGE(PG8_SA(0, 1), cA + hstep, voffA);
        if (wr == 1) PG8_BAR;
        PG8_WAIT_V(4); PG8_BAR;
        PG8_STAGE(PG8_SB(1, 0), cB + kstep, voffB); PG8_STAGE(PG8_SA(1, 0), cA + kstep, voffA); PG8_STAGE(PG8_SB(1, 1), cB + hstep + kstep, voffB);
        PG8_WAIT_V(6); PG8_BAR;
    }
    for (;;) {
        const bool has_next = S.next(ui + 1, nxt);
        const char* nA = has_next ? (const char*)g.A + (size_t)nxt.pm * tstep : cA; const char* nB = has_next ? (const char*)g.Bt + (size_t)nxt.pn * tstep : cB;
        for (int t = 0; t < nt; t += 2) {
            const bool last = (t == nt - 2);
            const char* a1 = cA + (size_t)(t + 1) * kstep;
            const char* a2 = last ? nA : cA + (size_t)(t + 2) * kstep; const char* b2 = last ? nB : cB + (size_t)(t + 2) * kstep;
            const char* a3 = a2 + kstep; const char* b3 = b2 + kstep;
            if (last && has_next) S.a_ready(nxt);
            if constexpr (SP2) {
            PG8_LDB(B0, 0, 0); PG8_LDB(B1, 0, 1); PG8_SCHED; PG8_LDA(At, 0, 0); PG8_STAGE(PG8_SA(1, 1), a1 + hstep, voffA);
            PG8_WAIT_V(8); PG8_WAIT_L(0); PG8_BAR; PG8_MMA(0, 0, At, B0); PG8_MMA(0, 1, At, B1); PG8_BAR; PG8_SCHED;
            PG8_LDA(At, 0, 1); PG8_STAGE(PG8_SB(0, 0), b2, voffB); PG8_STAGE(PG8_SB(0, 1), b2 + hstep, voffB); PG8_STAGE(PG8_SA(0, 0), a2, voffA);
            PG8_WAIT_V(8); PG8_WAIT_L(0); PG8_BAR; PG8_MMA(1, 0, At, B0); PG8_MMA(1, 1, At, B1); PG8_BAR; PG8_SCHED;
            PG8_LDB(B0, 1, 0); PG8_LDB(B1, 1, 1); PG8_SCHED; PG8_LDA(At, 1, 0); PG8_STAGE(PG8_SA(0, 1), a2 + hstep, voffA);
            PG8_WAIT_V(8); PG8_WAIT_L(0); PG8_BAR; PG8_MMA(0, 0, At, B0); PG8_MMA(0, 1, At, B1); PG8_BAR; PG8_SCHED;
            PG8_LDA(At, 1, 1); PG8_STAGE(PG8_SB(1, 0), b3, voffB); PG8_STAGE(PG8_SB(1, 1), b3 + hstep, voffB); PG8_STAGE(PG8_SA(1, 0), a3, voffA);
            PG8_WAIT_V(8); PG8_WAIT_L(0); PG8_BAR; PG8_MMA(1, 0, At, B0); PG8_MMA(1, 1, At, B1); PG8_BAR; PG8_SCHED;
            } else {
            PG8_LDB(B0, 0, 0); PG8_SCHED; PG8_LDA(At, 0, 0); PG8_STAGE(PG8_SA(1, 1), a1 + hstep, voffA);
            PG8_WAIT_L(8); PG8_BAR; PG8_WAIT_L(0); PG8_MMA(0, 0, At, B0); PG8_BAR; PG8_SCHED;
            PG8_LDB(B1, 0, 1); PG8_STAGE(PG8_SB(0, 0), b2, voffB);
            PG8_BAR; PG8_WAIT_L(0); PG8_MMA(0, 1, At, B1); PG8_BAR;
            PG8_LDA(At, 0, 1); PG8_STAGE(PG8_SA(0, 0), a2, voffA);
            PG8_BAR; PG8_WAIT_L(0); PG8_MMA(1, 0, At, B0); PG8_BAR; PG8_SCHED;
            PG8_STAGE(PG8_SB(0, 1), b2 + hstep, voffB);
            PG8_WAIT_V(6); PG8_BAR; PG8_MMA(1, 1, At, B1); PG8_BAR;
            PG8_LDB(B0, 1, 0); PG8_SCHED; PG8_LDA(At, 1, 0); PG8_STAGE(PG8_SA(0, 1), a2 + hstep, voffA);
            PG8_WAIT_L(8); PG8_BAR; PG8_WAIT_L(0); PG8_MMA(0, 0, At, B0); PG8_BAR; PG8_SCHED;
            PG8_LDB(B1, 1, 1); PG8_STAGE(PG8_SB(1, 0), b3, voffB);
            PG8_BAR; PG8_WAIT_L(0); PG8_MMA(0, 1, At, B1); PG8_BAR;
            PG8_LDA(At, 1, 1); PG8_STAGE(PG8_SA(1, 0), a3, voffA);
            PG8_BAR; PG8_WAIT_L(0); PG8_MMA(1, 0, At, B0); PG8_BAR; PG8_SCHED;
            PG8_STAGE(PG8_SB(1, 1), b3 + hstep, voffB);
            PG8_WAIT_V(6); PG8_BAR; PG8_MMA(1, 1, At, B1); PG8_BAR;
            }
        }
        if constexpr (ALIGN_EPI) { if (wr == 0) PG8_BAR; }
        if constexpr (!Epi::AFTER_DRAIN) { E(acc, cur, wr, wc, fr, fq); S.done(cur); }
        if (!has_next) break;
#pragma unroll
        for (int a = 0; a < 2; ++a)
#pragma unroll
            for (int b = 0; b < 2; ++b)
#pragma unroll
                for (int m = 0; m < 4; ++m)
#pragma unroll
                    for (int n = 0; n < 2; ++n) acc[a][b][m][n] = (f32x4){0.f, 0.f, 0.f, 0.f};
        cur = nxt; cA = nA; cB = nB; ++ui;
        if constexpr (ALIGN_EPI) { if (wr == 1) PG8_BAR; }
    }
    PG8_WAIT_V(0);
    if constexpr (!ALIGN_EPI) { if (wr == 0) PG8_BAR; }
    PG8_BAR;
    if constexpr (Epi::AFTER_DRAIN) { E.fused(acc, cur, wr, wc, fr, fq, lds, wid, lane); S.done(cur); }
#undef PG8_SA
#undef PG8_SB
#undef PG8_STAGE
#undef PG8_LDA
#undef PG8_LDB
#undef PG8_MMA
#undef PG8_WAIT_V
#undef PG8_WAIT_L
#undef PG8_BAR
#undef PG8_SCHED
}
}

namespace cg = cooperative_groups;
#define LAS __attribute__((address_space(3)))
typedef unsigned short bf16;
typedef short bf16x8 __attribute__((ext_vector_type(8)));
typedef short s16x4 __attribute__((ext_vector_type(4)));
typedef float f32x4 __attribute__((ext_vector_type(4)));
typedef float f32x16 __attribute__((ext_vector_type(16)));
typedef unsigned u32x4 __attribute__((ext_vector_type(4)));
typedef unsigned u32x2 __attribute__((ext_vector_type(2)));

constexpr int SEQ = 8192, T = 16384, DM = 1024, FF = 4096, PLE = 256;
constexpr float EPS = 1e-6f;
constexpr size_t MiB = 1u << 20;
constexpr size_t WS_ROPE = 1 * MiB;
constexpr size_t WS_KMEAN = 2 * MiB;
constexpr size_t WS_W = 4 * MiB;
constexpr size_t W_QK = 0, W_V = 6 * MiB, W_OUT = 9 * MiB, W_FI = 11 * MiB, W_FO = 19 * MiB, W_G = 27 * MiB, W_P = 29 * MiB;
constexpr size_t WS_U = 36 * MiB;
constexpr size_t WS_QK = 68 * MiB;
constexpr size_t WS_VT = 164 * MiB;
constexpr size_t WS_HID = 68 * MiB;
constexpr size_t WS_Y = 212 * MiB;
constexpr size_t WS_PB = 276 * MiB;
constexpr size_t WS_END = 284 * MiB;
constexpr int LDS_BYTES = 147456;
constexpr int NTHREADS = 512;

struct Args {
    const float* x; const float* p; const int* pos;
    const float* w_in[4]; const float* w_out[4];
    const float *g_mix_pre, *g_mix_post, *g_ffn_pre, *g_ffn_post, *w_ff_in, *w_ff_out, *g_ple, *w_ple_gate, *w_ple;
    float* out; unsigned char* ws;
    int lo, hi, dump, lshift;
};

__device__ __forceinline__ float bf2f(unsigned short b) { return __uint_as_float((unsigned)b << 16); }
typedef float f32x2_t __attribute__((ext_vector_type(2))); typedef __bf16 bf16x2_t __attribute__((ext_vector_type(2)));
__device__ __forceinline__ unsigned pk2(float lo, float hi) { f32x2_t v = {lo, hi}; bf16x2_t b = __builtin_convertvector(v, bf16x2_t); return __builtin_bit_cast(unsigned, b); }
__device__ __forceinline__ float wave_sum(float v) {
#pragma unroll
    for (int o = 1; o < 64; o <<= 1) v += __shfl_xor(v, o);
    return v;
}
__device__ __forceinline__ float ex2(float x) { return __builtin_amdgcn_exp2f(x); }
__device__ __forceinline__ float lg2(float x) { return __builtin_amdgcn_logf(x); }

struct EpiF32 {
    static constexpr bool PERM = false, AFTER_DRAIN = false;
    float* O; int ldc;
    __device__ __forceinline__ void operator()(const pg8::f32x4 (&acc)[2][2][4][2], const pg8::Unit& u, int wr, int wc, int fr, int fq) const {
        const int row0 = u.pm * 256 + wr * 64 + fr, col0 = u.pn * 256 + wc * 32 + 4 * fq;
#pragma unroll
        for (int ai = 0; ai < 2; ++ai)
#pragma unroll
            for (int m = 0; m < 4; ++m) { float* rp = O + (size_t)(row0 + ai * 128 + m * 16) * ldc + col0;
#pragma unroll
                for (int bj = 0; bj < 2; ++bj)
#pragma unroll
                    for (int n = 0; n < 2; ++n) *(pg8::f32x4*)(rp + bj * 128 + n * 16) = acc[ai][bj][m][n]; }
    }
};
struct EpiGate {
    static constexpr bool PERM = true, AFTER_DRAIN = false;
    float* H; const bf16* PL; int ldc;
    __device__ __forceinline__ void operator()(const pg8::f32x4 (&acc)[2][2][4][2], const pg8::Unit& u, int wr, int wc, int fr, int fq) const {
        const int row0 = u.pm * 256 + wr * 64 + fr, col0 = u.pn * 256 + wc * 32 + 8 * fq;
#pragma unroll
        for (int ai = 0; ai < 2; ++ai)
#pragma unroll
            for (int m = 0; m < 4; ++m) { const size_t off = (size_t)(row0 + ai * 128 + m * 16) * ldc + col0;
#pragma unroll
                for (int bj = 0; bj < 2; ++bj) { const size_t o2 = off + bj * 128;
                    const u32x4 pw = *(const u32x4*)(PL + o2);
#pragma unroll
                    for (int n = 0; n < 2; ++n) { const pg8::f32x4 a = acc[ai][bj][m][n], hv = *(const pg8::f32x4*)(H + o2 + 4 * n); pg8::f32x4 r;
                        const unsigned w0 = n ? pw.z : pw.x, w1 = n ? pw.w : pw.y;
                        const float pl[4] = {__uint_as_float(w0 << 16), __uint_as_float(w0 & 0xffff0000u), __uint_as_float(w1 << 16), __uint_as_float(w1 & 0xffff0000u)};
#pragma unroll
                        for (int c = 0; c < 4; ++c) { const float g = 1.0f / (1.0f + __expf(-a[c])); r[c] = hv[c] + pl[c] * g; }
                        *(pg8::f32x4*)(H + o2 + 4 * n) = r; } } }
    }
};
template <int ACT  > struct EpiB16 {
    static constexpr bool PERM = true, AFTER_DRAIN = false;
    bf16* O; int ldc;
    __device__ __forceinline__ void operator()(const pg8::f32x4 (&acc)[2][2][4][2], const pg8::Unit& u, int wr, int wc, int fr, int fq) const {
        const int row0 = u.pm * 256 + wr * 64 + fr, col0 = u.pn * 256 + wc * 32 + 8 * fq;
#pragma unroll
        for (int ai = 0; ai < 2; ++ai)
#pragma unroll
            for (int m = 0; m < 4; ++m) { bf16* rp = O + (size_t)(row0 + ai * 128 + m * 16) * ldc + col0;
#pragma unroll
                for (int bj = 0; bj < 2; ++bj) { pg8::f32x4 v0 = acc[ai][bj][m][0], v1 = acc[ai][bj][m][1];
                    if (ACT == 2) {
#pragma unroll
                        for (int c = 0; c < 4; ++c) { const float a = fmaxf(v0[c], 0.f), b = fmaxf(v1[c], 0.f); v0[c] = a * a; v1[c] = b * b; } }
                    u32x4 w; w.x = pk2(v0[0], v0[1]); w.y = pk2(v0[2], v0[3]); w.z = pk2(v1[0], v1[1]); w.w = pk2(v1[2], v1[3]);
                    *(u32x4*)(rp + bj * 128) = w; } }
    }
};
struct EpiQK {
    static constexpr bool PERM = true, AFTER_DRAIN = false;
    bf16* O; int ldc; const float* cs; const float* sn; int rope_chunks;
    __device__ __forceinline__ void operator()(const pg8::f32x4 (&acc)[2][2][4][2], const pg8::Unit& u, int wr, int wc, int fr, int fq) const {
        const int row0 = u.pm * 256 + wr * 64 + fr, colw = u.pn * 256 + wc * 32;
        const bool ropew = ((wc & 1) == 0);
        const float sgn = (fq == 0) ? -1.f : 1.f;
#pragma unroll
        for (int ai = 0; ai < 2; ++ai)
#pragma unroll
            for (int m = 0; m < 4; ++m) { const int row = row0 + ai * 128 + m * 16; bf16* rp = O + (size_t)row * ldc + colw + 8 * fq;
#pragma unroll
                for (int bj = 0; bj < 2; ++bj) { pg8::f32x4 v0 = acc[ai][bj][m][0], v1 = acc[ai][bj][m][1];
                    const int c64 = (colw + bj * 128) >> 6;
                    if (ropew && c64 < rope_chunks) {
                        const pg8::f32x4 c0 = *(const pg8::f32x4*)(cs + row * 8), c1 = *(const pg8::f32x4*)(cs + row * 8 + 4);
                        const pg8::f32x4 s0 = *(const pg8::f32x4*)(sn + row * 8), s1 = *(const pg8::f32x4*)(sn + row * 8 + 4);
                        pg8::f32x4 o0, o1;
#pragma unroll
                        for (int c = 0; c < 4; ++c) { o0[c] = __shfl_xor(v0[c], 16); o1[c] = __shfl_xor(v1[c], 16); }
                        if (fq < 2) {
#pragma unroll
                            for (int c = 0; c < 4; ++c) { v0[c] = v0[c] * c0[c] + sgn * o0[c] * s0[c]; v1[c] = v1[c] * c1[c] + sgn * o1[c] * s1[c]; } }
                    }
                    u32x4 w; w.x = pk2(v0[0], v0[1]); w.y = pk2(v0[2], v0[3]); w.z = pk2(v1[0], v1[1]); w.w = pk2(v1[2], v1[3]);
                    *(u32x4*)(rp + bj * 128) = w; } }
    }
};

__device__ __forceinline__ void tr_item(const float* __restrict__ W, int N, int K, int c0, int nc, bf16* WT, int r0, float* scr, int item, int nblk, int lane) {
    const int kb = item / nblk, nb = item % nblk, k0 = 64 * kb, n0 = 32 * nb;
    const int n4 = (lane & 7) * 4, col = n0 + n4;
#pragma unroll
    for (int i = 0; i < 8; ++i) { const int kk = 8 * i + (lane >> 3);
        const f32x4 v = (col < nc) ? *(const f32x4*)(W + (size_t)(k0 + kk) * N + c0 + col) : (f32x4){0.f, 0.f, 0.f, 0.f};
        scr[kk * 33 + n4] = v[0]; scr[kk * 33 + n4 + 1] = v[1]; scr[kk * 33 + n4 + 2] = v[2]; scr[kk * 33 + n4 + 3] = v[3]; }
    asm volatile("s_waitcnt lgkmcnt(0)" ::: "memory");
    const int c = lane & 7;
#pragma unroll
    for (int j = 0; j < 4; ++j) { const int n = (lane >> 3) + 8 * j; const float* s = scr + (8 * c) * 33 + n;
        u32x4 o; o.x = pk2(s[0 * 33], s[1 * 33]); o.y = pk2(s[2 * 33], s[3 * 33]); o.z = pk2(s[4 * 33], s[5 * 33]); o.w = pk2(s[6 * 33], s[7 * 33]);
        *(u32x4*)(WT + (size_t)(r0 + n0 + n) * K + k0 + 8 * c) = o; }
    asm volatile("s_waitcnt lgkmcnt(0)" ::: "memory");
}
__device__ __forceinline__ void tr_seg(const float* W, int N, int K, int c0, int nc, int ncpad, bf16* WT, int r0, float* scr, int gw, int NGW, int lane, int& off) {
    const int nblk = ncpad / 32, nitems = (K / 256) * nblk;
    int first = gw - off; if (first < 0) first += NGW;
    off += nitems; while (off >= NGW) off -= NGW;
    for (int it = first; it < nitems; it += NGW) { const int kb4 = it / nblk, nb = it % nblk;
#pragma unroll 1
        for (int kk = 0; kk < 4; ++kk) tr_item(W, N, K, c0, nc, WT, r0, scr, (kb4 * 4 + kk) * nblk + nb, nblk, lane); }
}

__device__ __forceinline__ void store_u(bf16* urow, const f32x4 (&v)[4], float r, const float* g, int lane) {
#pragma unroll
    for (int j = 0; j < 4; ++j) { const f32x4 gg = *(const f32x4*)(g + lane * 4 + 256 * j);
        u32x2 w; w.x = pk2(v[j][0] * r * gg[0], v[j][1] * r * gg[1]); w.y = pk2(v[j][2] * r * gg[2], v[j][3] * r * gg[3]);
        *(u32x2*)(urow + lane * 4 + 256 * j) = w; }
}
__device__ __forceinline__ void norm1_row(const float* hrow, const float* g, bf16* urow, int lane) {
    f32x4 v[4]; float ss = 0.f;
#pragma unroll
    for (int j = 0; j < 4; ++j) { v[j] = *(const f32x4*)(hrow + lane * 4 + 256 * j); ss += v[j][0] * v[j][0] + v[j][1] * v[j][1] + v[j][2] * v[j][2] + v[j][3] * v[j][3]; }
    const float r = rsqrtf(wave_sum(ss) * (1.f / DM) + EPS);
    store_u(urow, v, r, g, lane);
}
__device__ __forceinline__ void norm2_row(const float* base, const bf16* yrow, const float* gpost, const float* gnext, float* hout, bf16* urow, int lane) {
    f32x4 y[4], h[4]; float ss = 0.f;
#pragma unroll
    for (int j = 0; j < 4; ++j) { const u32x2 yw = *(const u32x2*)(yrow + lane * 4 + 256 * j); y[j] = (f32x4){__uint_as_float(yw.x << 16), __uint_as_float(yw.x & 0xffff0000u), __uint_as_float(yw.y << 16), __uint_as_float(yw.y & 0xffff0000u)}; h[j] = *(const f32x4*)(base + lane * 4 + 256 * j);
        ss += y[j][0] * y[j][0] + y[j][1] * y[j][1] + y[j][2] * y[j][2] + y[j][3] * y[j][3]; }
    const float ry = rsqrtf(wave_sum(ss) * (1.f / DM) + EPS);
    float s2 = 0.f;
#pragma unroll
    for (int j = 0; j < 4; ++j) { const f32x4 gg = *(const f32x4*)(gpost + lane * 4 + 256 * j);
#pragma unroll
        for (int c = 0; c < 4; ++c) { h[j][c] = h[j][c] + y[j][c] * ry * gg[c]; s2 += h[j][c] * h[j][c]; }
        *(f32x4*)(hout + lane * 4 + 256 * j) = h[j]; }
    const float rh = rsqrtf(wave_sum(s2) * (1.f / DM) + EPS);
    store_u(urow, h, rh, gnext, lane);
}

__device__ __forceinline__ int crow(int r, int hi) { return (r & 3) + 8 * (r >> 2) + 4 * hi; }
__device__ __forceinline__ void ld_frags(bf16x8 (&f)[4], const bf16* p) {
#pragma unroll
    for (int d0 = 0; d0 < 4; ++d0) f[d0] = *(const bf16x8*)(p + 16 * d0);
}
__device__ __forceinline__ f32x16 qk_tile(const bf16x8 (&kf)[4], const bf16x8 (&qf)[4]) {
    f32x16 s = {};
#pragma unroll
    for (int d0 = 0; d0 < 4; ++d0) s = __builtin_amdgcn_mfma_f32_32x32x16_bf16(kf[d0], qf[d0], s, 0, 0, 0);
    asm volatile("" : "+v"(s) : "v"(kf[0]), "v"(kf[1]), "v"(kf[2]), "v"(kf[3]), "v"(qf[0]), "v"(qf[1]), "v"(qf[2]), "v"(qf[3]));
    return s;
}
__device__ __forceinline__ void ld_vt(bf16x8 (&vf)[2][2], const bf16* vp) {
#pragma unroll
    for (int db = 0; db < 2; ++db)
#pragma unroll
        for (int s = 0; s < 2; ++s) { const bf16* q = vp + (size_t)db * 32 * T + 16 * s; const s16x4 a = *(const s16x4*)q, b = *(const s16x4*)(q + 8);
            vf[db][s] = (bf16x8){a[0], a[1], a[2], a[3], b[0], b[1], b[2], b[3]}; }
}
__device__ __forceinline__ void pv_acc(f32x16 (&o)[2], const bf16x8 (&vf)[2][2], const f32x16& p) {
#pragma unroll
    for (int s = 0; s < 2; ++s) { u32x4 w; w.x = pk2(p[8 * s], p[8 * s + 1]); w.y = pk2(p[8 * s + 2], p[8 * s + 3]); w.z = pk2(p[8 * s + 4], p[8 * s + 5]); w.w = pk2(p[8 * s + 6], p[8 * s + 7]);
        const bf16x8 pf = __builtin_bit_cast(bf16x8, w);
#pragma unroll
        for (int db = 0; db < 2; ++db) o[db] = __builtin_amdgcn_mfma_f32_32x32x16_bf16(vf[db][s], pf, o[db], 0, 0, 0); }
}
struct KV { bf16x8 k[4]; bf16x8 v[2][2]; };
__device__ __forceinline__ void ld_kv(KV& x, const bf16* kp, const bf16* vp) { ld_frags(x.k, kp); ld_vt(x.v, vp); }
constexpr float SC2 = 0.125f * 1.4426950408889634f;
__device__ __forceinline__ void sm_step(f32x16 s, unsigned am, int hi, float& m, float& l, f32x16 (&o)[2], const bf16x8 (&vf)[2][2]) {
    const unsigned am2 = am >> (4 * hi);
    float mx = -INFINITY;
#pragma unroll
    for (int r = 0; r < 16; ++r) { const bool ok = (am2 >> ((r & 3) + 8 * (r >> 2))) & 1u; s[r] = ok ? s[r] * SC2 : -INFINITY; mx = fmaxf(mx, s[r]); }
    mx = fmaxf(mx, __shfl_xor(mx, 32));
    const float mn = fmaxf(m, mx), ms = (mn == -INFINITY) ? 0.f : mn;
    const float alpha = ex2(m - ms);
    float sum = 0.f;
#pragma unroll
    for (int r = 0; r < 16; ++r) { s[r] = ex2(s[r] - ms); sum += s[r]; }
    l = l * alpha + sum; m = mn;
#pragma unroll
    for (int db = 0; db < 2; ++db)
#pragma unroll
        for (int r = 0; r < 16; ++r) o[db][r] *= alpha;
    pv_acc(o, vf, s);
}
__device__ __forceinline__ void sm_step64(f32x16 s0, f32x16 s1, unsigned am0, unsigned am1, int hi, float& m, float& l, f32x16 (&o)[2], const bf16x8 (&v0)[2][2], const bf16x8 (&v1)[2][2]) {
    const unsigned a0 = am0 >> (4 * hi), a1 = am1 >> (4 * hi);
    float mx = -INFINITY;
#pragma unroll
    for (int r = 0; r < 16; ++r) { const int bit = (r & 3) + 8 * (r >> 2);
        s0[r] = ((a0 >> bit) & 1u) ? s0[r] : -INFINITY; s1[r] = ((a1 >> bit) & 1u) ? s1[r] : -INFINITY; mx = fmaxf(mx, fmaxf(s0[r], s1[r])); }
    mx *= SC2;
    mx = fmaxf(mx, __shfl_xor(mx, 32));
    const float mn = fmaxf(m, mx), ms = (mn == -INFINITY) ? 0.f : mn;
    const float alpha = ex2(m - ms);
    float sum = 0.f;
#pragma unroll
    for (int r = 0; r < 16; ++r) { s0[r] = ex2(__builtin_fmaf(s0[r], SC2, -ms)); s1[r] = ex2(__builtin_fmaf(s1[r], SC2, -ms)); sum += s0[r] + s1[r]; }
    l = l * alpha + sum; m = mn;
#pragma unroll
    for (int db = 0; db < 2; ++db)
#pragma unroll
        for (int r = 0; r < 16; ++r) o[db][r] *= alpha;
    pv_acc(o, v0, s0);
    pv_acc(o, v1, s1);
}
__device__ __forceinline__ void write_o(bf16* obase, int ldo, f32x16 (&o)[2], float inv, int lane, bf16* stg) {
    const int r32 = lane & 31, hi = lane >> 5;
#pragma unroll
    for (int db = 0; db < 2; ++db)
#pragma unroll
        for (int g = 0; g < 4; ++g) { u32x2 w; w.x = pk2(o[db][4 * g] * inv, o[db][4 * g + 1] * inv); w.y = pk2(o[db][4 * g + 2] * inv, o[db][4 * g + 3] * inv);
            *(u32x2*)(stg + r32 * 72 + 32 * db + 8 * g + 4 * hi) = w; }
    asm volatile("s_waitcnt lgkmcnt(0)" ::: "memory");
#pragma unroll
    for (int i = 0; i < 4; ++i) { const int row = i * 8 + (lane >> 3), ch = lane & 7; const u32x4 v = *(const u32x4*)(stg + row * 72 + ch * 8); *(u32x4*)(obase + (size_t)row * ldo + ch * 8) = v; }
    asm volatile("s_waitcnt lgkmcnt(0)" ::: "memory");
}
__device__ __forceinline__ unsigned causal_bits(int t, int key0) { const int d = t - key0; return d >= 31 ? 0xffffffffu : (d < 0 ? 0u : ((2u << d) - 1u)); }
__device__ __forceinline__ unsigned lower_bits(int lo, int key0) { const int d = lo - key0; return d <= 0 ? 0xffffffffu : (d >= 32 ? 0u : (0xffffffffu << d)); }
constexpr int KV_OFF = 40960, KV_BUF = 18432, KV_VOFF = 9216;
struct KVLD { u32x4 k, v; };
__device__ __forceinline__ KVLD kv_issue(const bf16* Kb, int ldk, const bf16* Vb, int key0, int tid) {
    KVLD x; x.k = *(const u32x4*)(Kb + (size_t)(key0 + (tid >> 3)) * ldk + (tid & 7) * 8);
    x.v = *(const u32x4*)(Vb + (size_t)(tid >> 3) * T + key0 + (tid & 7) * 8); return x;
}
__device__ __forceinline__ void kv_store(unsigned char* buf, const KVLD& x, int tid) {
    *(u32x4*)(buf + (tid >> 3) * 144 + (tid & 7) * 16) = x.k;
    *(u32x4*)(buf + KV_VOFF + (tid >> 3) * 144 + (tid & 7) * 16) = x.v;
}
__device__ __forceinline__ void kv_frags(KV& x, const unsigned char* buf, int sub, int r32, int hi) {
#pragma unroll
    for (int d0 = 0; d0 < 4; ++d0) x.k[d0] = *(const bf16x8*)(buf + (32 * sub + r32) * 144 + 32 * d0 + 16 * hi);
#pragma unroll
    for (int db = 0; db < 2; ++db)
#pragma unroll
        for (int ss = 0; ss < 2; ++ss) { const unsigned char* q = buf + KV_VOFF + (32 * db + r32) * 144 + 64 * sub + 32 * ss + 8 * hi; const s16x4 va = *(const s16x4*)q, vb = *(const s16x4*)(q + 16);
            x.v[db][ss] = (bf16x8){va[0], va[1], va[2], va[3], vb[0], vb[1], vb[2], vb[3]}; }
}
__device__ __forceinline__ bool grp_unit(int i, int wg, int G, int nbh, int& bh, int& grp) {
    if (G == 256 && nbh == 32) { if (i >= 4) return false; const int j = wg >> 3, s = j >> 2; bh = (wg & 7) * 4 + (j & 3); grp = (i == 0) ? s : (i == 1) ? 15 - s : (i == 2) ? 16 + s : 31 - s; return true; }
    if (G == 256 && nbh == 16) { if (i >= 2) return false; const int j = wg >> 3, s = j >> 1; bh = (wg & 7) * 2 + (j & 1); grp = (i == 0) ? s : 31 - s; return true; }
    const int u = wg + i * G; if (u >= nbh * 32) return false; bh = u >> 5; grp = u & 31; return true;
}

__device__ __forceinline__ void sb_step(f32x16 s, int t, int key0, int hi, float& R, f32x16 (&o)[2], const bf16x8 (&vf)[2][2]) {
    float lf[16], ls[16]; bool ok[16];
#pragma unroll
    for (int r = 0; r < 16; ++r) { const int key = key0 + crow(r, hi); ok[r] = key < t; const float z2 = s[r] * SC2;
        const float sp = fmaxf(z2, 0.f) + lg2(1.f + ex2(-fabsf(z2))); lf[r] = ok[r] ? -sp : 0.f; ls[r] = z2 - sp; }
    float Gs[4], PG[4];
#pragma unroll
    for (int g = 0; g < 4; ++g) { Gs[g] = (lf[4 * g] + lf[4 * g + 1]) + (lf[4 * g + 2] + lf[4 * g + 3]); PG[g] = __shfl_xor(Gs[g], 32); }
    float run = R;
#pragma unroll
    for (int g = 3; g >= 0; --g) { float acc = run + (hi == 0 ? PG[g] : 0.f);
#pragma unroll
        for (int ii = 3; ii >= 0; --ii) { const int r = 4 * g + ii; s[r] = ok[r] ? ex2(ls[r] + acc) : 0.f; acc += lf[r]; }
        run += Gs[g] + PG[g]; }
    R = run;
    pv_acc(o, vf, s);
}
__device__ __forceinline__ void attn_sb(const bf16* __restrict__ QK, const bf16* __restrict__ VT, bf16* O, unsigned char* lds, int wg, int G, int wave, int lane, int tid, bf16* stg) {
    const int r32 = lane & 31, hi = lane >> 5;
    unsigned* flag = (unsigned*)(lds + KV_OFF + 2 * KV_BUF);
    int bh, grp;
    for (int i = 0; grp_unit(i, wg, G, 32, bh, grp); ++i) {
        const int b = bh >> 4, h = bh & 15, tile = grp * 8 + wave, t0 = tile * 32, tok0 = b * SEQ + t0, t = t0 + r32, ktmax = grp * 8 + 7;
        bf16x8 qf[4]; ld_frags(qf, QK + (size_t)(tok0 + r32) * 2048 + h * 64 + 8 * hi);
        const bf16* Kb = QK + (size_t)(b * SEQ) * 2048 + 1024 + h * 64; const bf16* Vb = VT + (size_t)(h * 64) * T + b * SEQ;
        f32x16 o[2]; o[0] = f32x16{}; o[1] = f32x16{};
        float R = 0.f; bool done = false;
        if (tid == 0) flag[0] = 0u;
        const int k64max = grp * 4 + 3;
        kv_store(lds + KV_OFF + (k64max & 1) * KV_BUF, kv_issue(Kb, 2048, Vb, k64max * 64, tid), tid);
        __syncthreads();
        for (int k64 = k64max; k64 >= 0; --k64) {
            KVLD nx = {}; if (k64 > 0) nx = kv_issue(Kb, 2048, Vb, (k64 - 1) * 64, tid);
#pragma unroll 1
            for (int sub = 1; sub >= 0; --sub) { const int kt = 2 * k64 + sub;
                if (kt <= tile && !done) { KV x; kv_frags(x, lds + KV_OFF + (k64 & 1) * KV_BUF, sub, r32, hi);
                    sb_step(qk_tile(x.k, qf), t, kt * 32, hi, R, o, x.v);
                    if (__all(R < -150.f)) { done = true; if (lane == 0) atomicOr(flag, 1u << wave); } } }
            if (k64 > 0) kv_store(lds + KV_OFF + ((k64 - 1) & 1) * KV_BUF, nx, tid);
            __syncthreads();
            const bool alldone = (flag[0] == 0xffu);
            __syncthreads();
            if (alldone) break;
        }
        __syncthreads();
        write_o(O + (size_t)tok0 * 1024 + h * 64, 1024, o, 1.f, lane, stg);
    }
}

__device__ __forceinline__ void attn_dil(const bf16* __restrict__ QK, const bf16* __restrict__ VT, bf16* O, unsigned char* lds, int wg, int G, int wave, int lane, int tid, bf16* stg) {
    const int r32 = lane & 31, hi = lane >> 5;
    int bh, grp;
    for (int i = 0; grp_unit(i, wg, G, 16, bh, grp); ++i) {
        const int b = bh >> 3, h = bh & 7, tile = grp * 8 + wave, t0 = tile * 32, tok0 = b * SEQ + t0, t = t0 + r32, ktmax = grp * 8 + 7;
        f32x16 o[2]; o[0] = f32x16{}; o[1] = f32x16{};
        float m = -INFINITY, l = 0.f;
#pragma unroll 1
        for (int g = 0; g < 3; ++g) {
            const int dil = (g == 0) ? 1 : (g == 1 ? 4 : 16);
            const unsigned pat = ((g == 0) ? 0xffffffffu : (g == 1 ? 0x11111111u : 0x00010001u)) << (t & (dil - 1));
            bf16x8 qf[4]; ld_frags(qf, QK + (size_t)(tok0 + r32) * 3072 + g * 1024 + h * 64 + 8 * hi);
            const bf16* Kb = QK + (size_t)(b * SEQ) * 3072 + g * 1024 + 512 + h * 64; const bf16* Vb = VT + (size_t)(g * 512 + h * 64) * T + b * SEQ;
            const int lo = t - 128 * dil;
            int k640 = grp * 256 - 128 * dil; k640 = k640 < 0 ? 0 : (k640 >> 6);
            const int k64max = grp * 4 + 3;
            kv_store(lds + KV_OFF + (k640 & 1) * KV_BUF, kv_issue(Kb, 3072, Vb, k640 * 64, tid), tid);
            KVLD n1 = kv_issue(Kb, 3072, Vb, (k640 + 1 <= k64max ? k640 + 1 : k64max) * 64, tid);
            __syncthreads();
            for (int k64 = k640; k64 <= k64max; ++k64) {
                const KVLD n2 = kv_issue(Kb, 3072, Vb, (k64 + 2 <= k64max ? k64 + 2 : k64max) * 64, tid);
                { const int key0 = k64 * 64;
                  const unsigned am0 = pat & causal_bits(t, key0) & lower_bits(lo, key0), am1 = pat & causal_bits(t, key0 + 32) & lower_bits(lo, key0 + 32);
                  if (__ballot((am0 | am1) != 0u) != 0ull) { KV x0, x1; kv_frags(x0, lds + KV_OFF + (k64 & 1) * KV_BUF, 0, r32, hi); kv_frags(x1, lds + KV_OFF + (k64 & 1) * KV_BUF, 1, r32, hi);
                      sm_step64(qk_tile(x0.k, qf), qk_tile(x1.k, qf), am0, am1, hi, m, l, o, x0.v, x1.v); } }
                if (k64 < k64max) kv_store(lds + KV_OFF + ((k64 + 1) & 1) * KV_BUF, n1, tid);
                __syncthreads();
                n1 = n2;
            }
        }
        const float lt = l + __shfl_xor(l, 32);
        write_o(O + (size_t)tok0 * 512 + h * 64, 512, o, 1.f / lt, lane, stg);
    }
}

constexpr int LDC = 2816;
__device__ __forceinline__ unsigned mono_key(float f) { const unsigned u = __float_as_uint(f); return (u & 0x80000000u) ? ~u : (u | 0x80000000u); }
__device__ __forceinline__ f32x16 score_tile(const bf16* kip, const bf16x8* qis, const float (&wi)[8], int lane) {
    bf16x8 kf[4]; ld_frags(kf, kip);
    f32x16 sc = {};
    asm volatile("" : "+v"(lane));
#pragma unroll 4
    for (int h = 0; h < 8; ++h) { bf16x8 qf[4];
#pragma unroll
        for (int d0 = 0; d0 < 4; ++d0) qf[d0] = qis[(h * 4 + d0) * 64 + lane];
        const f32x16 s = qk_tile(kf, qf);
#pragma unroll
        for (int r = 0; r < 16; ++r) sc[r] = __builtin_fmaf(wi[h], fmaxf(s[r], 0.f), sc[r]); }
    return sc;
}
__device__ __forceinline__ void dsa_select(unsigned char* lds, const bf16* __restrict__ QK, unsigned* MASK, int wg, int G, int wave, int lane, int tid) {
    unsigned* hist = (unsigned*)lds;
    bf16x8* qis = (bf16x8*)(lds + 66048);
    unsigned* pref = (unsigned*)(lds + 99328); unsigned* need = pref + 32; unsigned* flag = pref + 64;
    unsigned* ccount = pref + 96; unsigned* ckey = pref + 128; unsigned* cpos = pref + 384;
    const int r32 = lane & 31, hi = lane >> 5;
    for (int j = wg; j < 512; j += G) {
        const int b = j >> 8, tile = (j < 256) ? j : 511 - j, t0 = tile * 32, tok0 = b * SEQ + t0, t = t0 + r32;
        float wi[8];
        const bf16* qrow = QK + (size_t)(tok0 + r32) * LDC;
#pragma unroll
        for (int d0 = 0; d0 < 4; ++d0) qis[(wave * 4 + d0) * 64 + lane] = *(const bf16x8*)(qrow + 2048 + wave * 64 + 16 * d0 + 8 * hi);
        { const bf16x8 w8 = *(const bf16x8*)(qrow + 2624);
#pragma unroll
          for (int h = 0; h < 8; ++h) wi[h] = bf2f((unsigned short)w8[h]); }
        const bf16* kib = QK + (size_t)(b * SEQ + r32) * LDC + 2560 + 8 * hi;
        const int nkt = tile + 1;
        unsigned thrk = 0u; bool maskdone = false;
        if (tid < 32) { pref[tid] = 0u; need[tid] = 256u; }
        __syncthreads();
        if (t0 >= 256) {
            bool done = false;
#pragma unroll 1
            for (int lvl = 0; lvl < 4 && !done; ++lvl) {
                const int sh = (lvl == 0) ? 22 : (lvl == 1 ? 12 : (lvl == 2 ? 2 : 0)), nb = (lvl == 3) ? 2 : 10;
                const unsigned bmask = (1u << nb) - 1u;
                for (int i = tid; i < 32 * 513 / 4; i += NTHREADS) ((u32x4*)hist)[i] = (u32x4){0u, 0u, 0u, 0u};
                if (tid == 0) { flag[0] = 1u; flag[1] = 0u; }
                if (lvl == 2 && tid < 32) ccount[tid] = 0u;
                __syncthreads();
                const unsigned mypref = pref[r32];
#pragma unroll 1
                for (int kt = wave; kt < nkt; kt += 8) {
                    const f32x16 sc = score_tile(kib + (size_t)(kt * 32) * LDC, qis, wi, lane);
                    unsigned word = 0u;
#pragma unroll
                    for (int r = 0; r < 16; ++r) { const int key = kt * 32 + crow(r, hi); const unsigned k = mono_key(sc[r]);
                        const bool caus = key <= t; bool ok = caus; if (lvl > 0) ok = ok && ((k >> (sh + nb)) == mypref);
                        const unsigned bin = (k >> sh) & bmask;
                        if (ok) atomicAdd(&hist[r32 * 513 + (bin >> 1)], 1u << (16 * (bin & 1u)));
                        if (lvl == 2) {
                            if (caus && (k >> 12) > mypref) word |= 1u << crow(r, hi);
                            if (ok) { const unsigned slot = atomicAdd(&ccount[r32], 1u); if (slot < 8u) { ckey[r32 * 8 + slot] = k; cpos[r32 * 8 + slot] = (unsigned)key; } else flag[1] = 1u; } } }
                    if (lvl == 2) { word |= __shfl_xor(word, 32); if (hi == 0) MASK[(size_t)(tok0 + r32) * 256 + kt] = word; }
                }
                __syncthreads();
#pragma unroll 1
                for (int qq = 0; qq < 4; ++qq) { const int q = 4 * wave + qq; const unsigned nd = need[q];
                    const int base = q * 513 + 8 * (63 - lane);
                    unsigned tot = 0u;
#pragma unroll
                    for (int w = 0; w < 8; ++w) { const unsigned x = hist[base + w]; tot += (x & 0xffffu) + (x >> 16); }
                    unsigned incl = tot;
#pragma unroll
                    for (int off = 1; off < 64; off <<= 1) { const unsigned v = __shfl_up(incl, off); if (lane >= off) incl += v; }
                    const unsigned long long bal = __ballot(incl >= nd);
                    const int cl = bal ? (__ffsll((long long)bal) - 1) : 63;
                    if (lane == cl) { unsigned above = incl - tot, cb = 0u; int bsel = 16 * (63 - lane);
                        for (int jb = 15; jb >= 0; --jb) { const unsigned x = hist[base + (jb >> 1)]; const unsigned c = (jb & 1) ? (x >> 16) : (x & 0xffffu);
                            if (above + c >= nd) { bsel = 16 * (63 - lane) + jb; cb = c; break; } above += c; }
                        pref[q] = (pref[q] << nb) | (unsigned)bsel; need[q] = nd - above;
                        if (cb != nd - above) flag[0] = 0u; }
                }
                __syncthreads();
                done = (flag[0] != 0u) || (lvl == 3);
                if (done) thrk = pref[r32] << sh;
                if (done && lvl == 2 && flag[1] == 0u) {
                    if (tid < 256) { const int q = tid >> 3; const unsigned slot = tid & 7;
                        if (slot < ccount[q]) { const unsigned tk = pref[q] << sh, pz = cpos[q * 8 + slot];
                            if (ckey[q * 8 + slot] >= tk) atomicOr(&MASK[(size_t)(tok0 + q) * 256 + (pz >> 5)], 1u << (pz & 31u)); } }
                    maskdone = true; }
                __syncthreads();
            }
        }
        if (!maskdone)
#pragma unroll 1
        for (int kt = wave; kt < nkt; kt += 8) {
            const f32x16 sc = score_tile(kib + (size_t)(kt * 32) * LDC, qis, wi, lane);
            unsigned word = 0u;
#pragma unroll
            for (int r = 0; r < 16; ++r) { const int key = kt * 32 + crow(r, hi); const unsigned k = mono_key(sc[r]); const bool sel = (key <= t) && (k >= thrk); word |= (sel ? 1u : 0u) << crow(r, hi); }
            word |= __shfl_xor(word, 32);
            if (hi == 0) MASK[(size_t)(tok0 + r32) * 256 + kt] = word;
        }
        __syncthreads();
    }
}
__device__ __forceinline__ void attn_dsa(const bf16* __restrict__ QK, const bf16* __restrict__ VT, const unsigned* __restrict__ MASK, bf16* O, unsigned char* lds, int wg, int G, int wave, int lane, int tid, bf16* stg) {
    const int r32 = lane & 31, hi = lane >> 5;
    for (int i = 0; ; ++i) {
        int bh, grp;
        if (G == 256) { if (i >= 2) break; const int j = wg >> 3, s = j >> 2; bh = (wg & 7) * 4 + (j & 3); grp = (i == 0) ? s : 15 - s; }
        else { const int u = wg + i * G; if (u >= 512) break; bh = u >> 4; grp = u & 15; }
        const int b = bh >> 4, h = bh & 15, mt = grp * 8 + wave, tileA = 2 * mt, tok0 = b * SEQ + tileA * 32, k64max = grp * 8 + 7;
        bf16x8 qfA[4], qfB[4]; ld_frags(qfA, QK + (size_t)(tok0 + r32) * LDC + h * 64 + 8 * hi); ld_frags(qfB, QK + (size_t)(tok0 + 32 + r32) * LDC + h * 64 + 8 * hi);
        const bf16* Kb = QK + (size_t)(b * SEQ) * LDC + 1024 + h * 64; const bf16* Vb = VT + (size_t)(h * 64) * T + b * SEQ;
        f32x16 oA[2], oB[2]; oA[0] = f32x16{}; oA[1] = f32x16{}; oB[0] = f32x16{}; oB[1] = f32x16{};
        float mA = -INFINITY, lA = 0.f, mB = -INFINITY, lB = 0.f;
        const unsigned* mrowA = MASK + (size_t)(tok0 + r32) * 256; const unsigned* mrowB = mrowA + 32 * 256;
        kv_store(lds + KV_OFF, kv_issue(Kb, LDC, Vb, 0, tid), tid);
        KVLD n1 = kv_issue(Kb, LDC, Vb, (k64max >= 1 ? 1 : 0) * 64, tid);
        __syncthreads();
        for (int k64 = 0; k64 <= k64max; ++k64) {
            const int k2 = k64 + 2 <= k64max ? k64 + 2 : k64max;
            const KVLD n2 = kv_issue(Kb, LDC, Vb, k2 * 64, tid);
            if (k64 <= mt) {
                const u32x2 mwA = *(const u32x2*)(mrowA + 2 * k64), mwB = *(const u32x2*)(mrowB + 2 * k64);
                { KV x; kv_frags(x, lds + KV_OFF + (k64 & 1) * KV_BUF, 0, r32, hi);
                  sm_step(qk_tile(x.k, qfA), mwA.x, hi, mA, lA, oA, x.v); sm_step(qk_tile(x.k, qfB), mwB.x, hi, mB, lB, oB, x.v); }
                { KV x; kv_frags(x, lds + KV_OFF + (k64 & 1) * KV_BUF, 1, r32, hi);
                  if (k64 < mt) sm_step(qk_tile(x.k, qfA), mwA.y, hi, mA, lA, oA, x.v);
                  sm_step(qk_tile(x.k, qfB), mwB.y, hi, mB, lB, oB, x.v); } }
            if (k64 < k64max) kv_store(lds + KV_OFF + ((k64 + 1) & 1) * KV_BUF, n1, tid);
            __syncthreads();
            n1 = n2;
        }
        const float ltA = lA + __shfl_xor(lA, 32), ltB = lB + __shfl_xor(lB, 32);
        write_o(O + (size_t)tok0 * 1024 + h * 64, 1024, oA, 1.f / ltA, lane, stg);
        write_o(O + (size_t)(tok0 + 32) * 1024 + h * 64, 1024, oB, 1.f / ltB, lane, stg);
    }
}

__device__ __forceinline__ void moba_kmean(const bf16* __restrict__ QK, float* KM, int gw, int NGW, int lane) {
    for (int u = gw; u < 1024; u += NGW) { const int b = u >> 9, h = (u >> 5) & 15, blk = u & 31;
        const bf16* kp = QK + (size_t)(b * SEQ + blk * 256) * 2048 + 1024 + h * 64 + lane;
        float s = 0.f;
        for (int jk = 0; jk < 256; ++jk) s += bf2f(kp[(size_t)jk * 2048]);
        KM[u * 64 + lane] = s * (1.f / 256.f); }
}
__device__ __forceinline__ unsigned moba_gate(const bf16* qrow, const float* km, int cur) {
    unsigned sel = 0u;
    if (cur > 0) {
        float qv[64];
#pragma unroll
        for (int c = 0; c < 8; ++c) { const bf16x8 q8 = *(const bf16x8*)(qrow + 8 * c);
#pragma unroll
            for (int e = 0; e < 8; ++e) qv[8 * c + e] = bf2f((unsigned short)q8[e]); }
        float v0 = -INFINITY, v1 = -INFINITY, v2 = -INFINITY; int i0 = -1, i1 = -1, i2 = -1;
#pragma unroll 1
        for (int blk = 0; blk < cur; ++blk) { const float* kr = km + blk * 64; float g0 = 0.f, g1 = 0.f;
#pragma unroll
            for (int dd = 0; dd < 64; dd += 2) { g0 = __builtin_fmaf(qv[dd], kr[dd], g0); g1 = __builtin_fmaf(qv[dd + 1], kr[dd + 1], g1); }
            const float g = g0 + g1;
            if (g > v2) { if (g > v1) { v2 = v1; i2 = i1; if (g > v0) { v1 = v0; i1 = i0; v0 = g; i0 = blk; } else { v1 = g; i1 = blk; } } else { v2 = g; i2 = blk; } } }
        if (i0 >= 0) sel |= 1u << i0; if (i1 >= 0) sel |= 1u << i1; if (i2 >= 0) sel |= 1u << i2;
    }
    return sel;
}
__device__ __forceinline__ void attn_moba(const bf16* __restrict__ QK, const bf16* __restrict__ VT, const float* __restrict__ KM, bf16* O, unsigned char* lds, int wg, int G, int wave, int lane, int tid, bf16* stg) {
    const int r32 = lane & 31, hi = lane >> 5;
    unsigned* flag = (unsigned*)(lds + KV_OFF + 2 * KV_BUF);
    for (int i = 0; ; ++i) {
        int bh, grp;
        if (G == 256) { if (i >= 2) break; const int j = wg >> 3, s = j >> 2; bh = (wg & 7) * 4 + (j & 3); grp = (i == 0) ? s : 15 - s; }
        else { const int u = wg + i * G; if (u >= 512) break; bh = u >> 4; grp = u & 15; }
        const int b = bh >> 4, h = bh & 15, mt = grp * 8 + wave, tileA = 2 * mt, t0 = tileA * 32, tok0 = b * SEQ + t0, tA = t0 + r32, tB = tA + 32;
        const int cur = mt >> 2, own0 = grp * 2, k64max = grp * 8 + 7;
        const bf16* qrowA = QK + (size_t)(tok0 + r32) * 2048 + h * 64; const bf16* qrowB = qrowA + (size_t)32 * 2048;
        if (tid == 0) flag[0] = 0u;
        int zoff = 0; asm volatile("" : "+v"(zoff));
        const float* km = KM + (size_t)(bh * 32) * 64 + zoff;
        const unsigned selA = moba_gate(qrowA, km, cur), selB = moba_gate(qrowB, km, cur);
        __syncthreads();
        { unsigned ws = 0u;
#pragma unroll 1
          for (int blk = 0; blk < cur; ++blk) if (__ballot(((selA | selB) >> blk) & 1u) != 0ull) ws |= 1u << blk;
          if (lane == 0 && ws) atomicOr(flag, ws); }
        __syncthreads();
        const unsigned wsel = flag[0];
        bf16x8 qfA[4], qfB[4]; ld_frags(qfA, qrowA + 8 * hi); ld_frags(qfB, qrowB + 8 * hi);
        const bf16* Kb = QK + (size_t)(b * SEQ) * 2048 + 1024 + h * 64; const bf16* Vb = VT + (size_t)(h * 64) * T + b * SEQ;
        f32x16 oA[2], oB[2]; oA[0] = f32x16{}; oA[1] = f32x16{}; oB[0] = f32x16{}; oB[1] = f32x16{};
        float mA = -INFINITY, lA = 0.f, mB = -INFINITY, lB = 0.f;
#define MOBA_NXT(k, out) do { int n_ = (k) + 1; while (n_ <= k64max && (n_ >> 2) < own0 && !((wsel >> (n_ >> 2)) & 1u)) n_ = ((n_ >> 2) + 1) << 2; out = n_; } while (0)
        int k64; MOBA_NXT(-1, k64);
        int kn; MOBA_NXT(k64, kn);
        int par = 0;
        kv_store(lds + KV_OFF, kv_issue(Kb, 2048, Vb, k64 * 64, tid), tid);
        KVLD n1 = kv_issue(Kb, 2048, Vb, (kn <= k64max ? kn : k64) * 64, tid);
        __syncthreads();
        while (k64 <= k64max) {
            int knn = kn; if (kn <= k64max) MOBA_NXT(kn, knn);
            const KVLD n2 = kv_issue(Kb, 2048, Vb, (knn <= k64max ? knn : k64) * 64, tid);
            const int blk = k64 >> 2;
            const unsigned fullA = ((selA >> blk) & 1u) ? 0xffffffffu : 0u, fullB = ((selB >> blk) & 1u) ? 0xffffffffu : 0u;
#pragma unroll 1
            for (int sub = 0; sub < 2; ++sub) { const int key0 = k64 * 64 + sub * 32;
                const unsigned amA = (blk < cur) ? fullA : causal_bits(tA, key0), amB = (blk < cur) ? fullB : causal_bits(tB, key0);
                if (__ballot((amA | amB) != 0u) != 0ull) { KV x; kv_frags(x, lds + KV_OFF + par * KV_BUF, sub, r32, hi);
                    sm_step(qk_tile(x.k, qfA), amA, hi, mA, lA, oA, x.v); sm_step(qk_tile(x.k, qfB), amB, hi, mB, lB, oB, x.v); } }
            if (kn <= k64max) kv_store(lds + KV_OFF + (par ^ 1) * KV_BUF, n1, tid);
            __syncthreads();
            par ^= 1; k64 = kn; kn = knn; n1 = n2;
        }
#undef MOBA_NXT
        const float ltA = lA + __shfl_xor(lA, 32), ltB = lB + __shfl_xor(lB, 32);
        write_o(O + (size_t)tok0 * 1024 + h * 64, 1024, oA, 1.f / ltA, lane, stg);
        write_o(O + (size_t)(tok0 + 32) * 1024 + h * 64, 1024, oB, 1.f / ltB, lane, stg);
    }
}

#define XB_TMO      128
#define XB_XCNT(j)  (256  + 64 * (j))
#define XB_XSUB(j)  (1280 + 64 * (j))
#define XB_XGEN(j)  (2304 + 64 * (j))
#define XB_TOP      3328
#define XB_TOPGEN   3392
#define XCD_BAR_WORDS 3456
#define XB_SPIN_CAP (1u << 18)

__device__ __forceinline__ unsigned xb_ld(unsigned* p)              { return __hip_atomic_load(p, __ATOMIC_RELAXED, __HIP_MEMORY_SCOPE_AGENT); }
__device__ __forceinline__ unsigned xb_add(unsigned* p, unsigned v) { return __hip_atomic_fetch_add(p, v, __ATOMIC_RELAXED, __HIP_MEMORY_SCOPE_AGENT); }
__device__ __forceinline__ unsigned xb_xcc_id() { return (unsigned)__builtin_amdgcn_s_getreg((3 << 11) | 20) & 0xFu; }
#define XB_SPIN(cond, bar) do { unsigned _sp = 0; while (cond) { __builtin_amdgcn_s_sleep(1); \
    if ((++_sp & 255u) == 0u) { if (xb_ld(&(bar)[XB_TMO])) break; if (_sp > XB_SPIN_CAP) { atomicAdd(&(bar)[XB_TMO], 1u); break; } } } } while (0)

struct XcdBarrier {
    unsigned* bar; unsigned x;
    volatile LAS unsigned* st;
};

__device__ __forceinline__ XcdBarrier xcd_barrier_post(unsigned* bar, volatile LAS unsigned* st) {
    XcdBarrier b; b.bar = bar; b.x = xb_xcc_id(); b.st = st;
    if (threadIdx.x == 0) (void)xb_add(&bar[XB_XCNT(b.x)], 1u);
    return b;
}
__device__ __forceinline__ void xcd_barrier_complete(unsigned* bar, unsigned x, unsigned& nloc, unsigned& nx) {
    const unsigned G = gridDim.x * gridDim.y * gridDim.z;
    unsigned sum, cnt, mine, sp = 0u;
    for (;;) {
        sum = 0u; cnt = 0u; mine = 0u;
#pragma unroll
        for (unsigned j = 0; j < 16; ++j) { const unsigned c = xb_ld(&bar[XB_XCNT(j)]); sum += c; cnt += (c > 0u) ? 1u : 0u; mine = (j == x) ? c : mine; }
        if (sum == G) break;
        __builtin_amdgcn_s_sleep(1);
        if ((++sp & 255u) == 0u) { if (xb_ld(&bar[XB_TMO])) break; if (sp > XB_SPIN_CAP) { atomicAdd(&bar[XB_TMO], 1u); break; } }
    }
    nloc = mine > 0u ? mine : 1u; nx = cnt > 0u ? cnt : 1u;
}

__device__ __forceinline__ void xcd_barrier(const XcdBarrier& b) {
    asm volatile("s_waitcnt vmcnt(0)" ::: "memory");
    __syncthreads();
    if (threadIdx.x == 0) {
        unsigned* bar = b.bar;
        __builtin_amdgcn_s_waitcnt(0);
        unsigned nloc = b.st[0], nx = b.st[1];
        if (nloc == 0u) { xcd_barrier_complete(bar, b.x, nloc, nx); b.st[0] = nloc; b.st[1] = nx; }
        const unsigned old = xb_add(&bar[XB_XSUB(b.x)], 1u);
        const unsigned gen = old / nloc;
        if (old + 1u == (gen + 1u) * nloc) {
            __builtin_amdgcn_fence(__ATOMIC_RELEASE, "agent");
            asm volatile("s_waitcnt vmcnt(0)" ::: "memory");
            const unsigned og = xb_add(&bar[XB_TOP], 1u);
            const unsigned tg = og / nx;
            if (og + 1u == (tg + 1u) * nx) xb_add(&bar[XB_TOPGEN], 1u);
            else XB_SPIN(xb_ld(&bar[XB_TOPGEN]) == tg, bar);
            __builtin_amdgcn_fence(__ATOMIC_ACQUIRE, "agent");
            xb_add(&bar[XB_XGEN(b.x)], 1u);
            asm volatile("s_waitcnt vmcnt(0)" ::: "memory");
        } else {
            XB_SPIN(xb_ld(&bar[XB_XGEN(b.x)]) == gen, bar);
            __builtin_amdgcn_fence(__ATOMIC_ACQUIRE, "agent");
            asm volatile("s_waitcnt vmcnt(0)" ::: "memory");
        }
    }
    __syncthreads();
}

#ifndef EN
#define EN 0xffff
#endif
#ifndef PROBE_ST
#define PROBE_ST -1
#endif
constexpr int NSTEP = 11 + (PROBE_ST >= 0 ? 1 : 0), NPHASE = 4 * NSTEP;
__global__ void __launch_bounds__(NTHREADS, 2) mega(Args a) {
    extern __shared__ __attribute__((aligned(16))) unsigned char lds[];
    cg::grid_group grid = cg::this_grid();
    typedef const __attribute__((address_space(4))) Args* kargp;
    unsigned long long apv = (unsigned long long)__builtin_amdgcn_kernarg_segment_ptr();
    PG8_LAS unsigned char* lds3 = (PG8_LAS unsigned char*)lds;
    const int ph_lo = ((kargp)apv)->lo, ph_hi = ((kargp)apv)->hi;
    if (threadIdx.x < 2) ((volatile LAS unsigned*)(lds3 + 143360))[threadIdx.x] = 0u;
    __syncthreads();
    XcdBarrier xbar = xcd_barrier_post((unsigned*)(((kargp)apv)->ws) + 1024, (volatile LAS unsigned*)(lds3 + 143360));
    if (ph_lo < 0) grid.sync();
    for (int ph = ph_lo; ph < ph_hi; ++ph) {
        asm volatile("" : "+s"(apv));
        const kargp ap = (kargp)apv;
        int tidv = threadIdx.x; asm volatile("" : "+v"(tidv));
        const int tid = tidv, lane = tid & 63, wave = __builtin_amdgcn_readfirstlane(tid >> 6);
        int wgv = blockIdx.x; asm volatile("" : "+s"(wgv));
        const int G = gridDim.x, wg = wgv, gw = wg * 8 + wave, NGW = G * 8;
#define a (*ap)
        unsigned char* ws = a.ws;
        float* cs = (float*)(ws + WS_ROPE); float* sn = cs + T * 8;
        float* KM = (float*)(ws + WS_KMEAN);
        bf16* Wqk = (bf16*)(ws + WS_W + W_QK); bf16* Wv = (bf16*)(ws + WS_W + W_V); bf16* Wo = (bf16*)(ws + WS_W + W_OUT);
        bf16* Wfi = (bf16*)(ws + WS_W + W_FI); bf16* Wfo = (bf16*)(ws + WS_W + W_FO); bf16* Wg = (bf16*)(ws + WS_W + W_G); bf16* Wp = (bf16*)(ws + WS_W + W_P);
        bf16* U = (bf16*)(ws + WS_U); bf16* QK = (bf16*)(ws + WS_QK); bf16* VT = (bf16*)(ws + WS_VT); bf16* HID = (bf16*)(ws + WS_HID);
        float* Y = (float*)(ws + WS_Y); unsigned* MASK = (unsigned*)(ws + WS_Y); bf16* PB = (bf16*)(ws + WS_PB);
        float* H = a.out;
        float* scr = (float*)(lds + wave * 16384);
        bf16* stg = (bf16*)(lds + wave * 4608);
        const int L0 = ph / NSTEP, L = (L0 + a.lshift) & 3, sk = ph % NSTEP, st = (PROBE_ST >= 0 && sk > PROBE_ST) ? sk - 1 : sk;
        const int nqk = (L == 1) ? 3072 : (L == 2 ? 2816 : 2048), nv = (L == 1) ? 1536 : 1024, kout = (L == 1) ? 512 : 1024;
        bool sync_after = true;
        if (st == 0) {
            if (L0 == 0) {
                for (int idx = gw * 64 + lane; idx < T * 8; idx += NGW * 64) { const int tk = idx >> 3, i = idx & 7;
                    const float inv = (i == 0) ? 1.0f : (i == 1) ? 0.1939227432012558f : (i == 2) ? 0.03760603070259094f : (i == 3) ? 0.007292664609849453f : (i == 4) ? 0.0014142135623842478f : (i == 5) ? 0.00027424818836152554f : (i == 6) ? 5.318296098266728e-05f : 1.0313386155758053e-05f;
                    const float ang = (float)a.pos[tk] * inv;
                    double rev = (double)ang * 0.15915494309189535; rev -= rint(rev);
                    const float rf = (float)rev;
                    cs[idx] = __builtin_amdgcn_cosf(rf); sn[idx] = __builtin_amdgcn_sinf(rf); }
            }
            int troff = 0;
            const float* win = a.w_in[L];
            if (L == 0 || L == 3) { tr_seg(win, 3072, 1024, 0, 2048, 2048, Wqk, 0, scr, gw, NGW, lane, troff); tr_seg(win, 3072, 1024, 2048, 1024, 1024, Wv, 0, scr, gw, NGW, lane, troff); }
            else if (L == 1) { for (int g = 0; g < 3; ++g) { tr_seg(win, 4608, 1024, g * 1536, 1024, 1024, Wqk, g * 1024, scr, gw, NGW, lane, troff); tr_seg(win, 4608, 1024, g * 1536 + 1024, 512, 512, Wv, g * 512, scr, gw, NGW, lane, troff); } }
            else { tr_seg(win, 3656, 1024, 0, 2048, 2048, Wqk, 0, scr, gw, NGW, lane, troff); tr_seg(win, 3656, 1024, 2048, 1024, 1024, Wv, 0, scr, gw, NGW, lane, troff); tr_seg(win, 3656, 1024, 3072, 584, 768, Wqk, 2048, scr, gw, NGW, lane, troff); }
            tr_seg(a.w_out[L], 1024, kout, 0, 1024, 1024, Wo, 0, scr, gw, NGW, lane, troff);
            tr_seg(a.w_ff_in + (size_t)L * DM * FF, FF, DM, 0, FF, FF, Wfi, 0, scr, gw, NGW, lane, troff);
            tr_seg(a.w_ff_out + (size_t)L * FF * DM, DM, FF, 0, DM, DM, Wfo, 0, scr, gw, NGW, lane, troff);
            tr_seg(a.w_ple_gate + (size_t)L * DM * DM, DM, DM, 0, DM, DM, Wg, 0, scr, gw, NGW, lane, troff);
            tr_seg(a.w_ple + (size_t)L * PLE * DM, DM, PLE, 0, DM, DM, Wp, 0, scr, gw, NGW, lane, troff);
            const float* hin = (L0 == 0) ? a.x : H;
            for (int r = gw; r < T; r += NGW) norm1_row(hin + (size_t)r * DM, a.g_mix_pre + L * DM, U + (size_t)r * DM, lane);
        } else if (st == 1) {
            { pg8::Gemm g{U, Wqk, T, nqk, DM}; pg8::StaticOrder S; S.init(T, nqk, G, wg);
              EpiQK E{QK, nqk, cs, sn, (L == 0) ? 0 : (L == 1 ? 48 : (L == 2 ? 41 : 32))};
              pg8::gemm_phase<EpiQK, pg8::StaticOrder, true, true>(lds3, g, S, E); }
            { pg8::Gemm g{Wv, U, nv, T, DM}; pg8::StaticOrder S; S.init(nv, T, G, wg);
              EpiB16<0> E{VT, T};
              pg8::gemm_phase<EpiB16<0>, pg8::StaticOrder, true, true>(lds3, g, S, E); }
        } else if (st == 2) {
            if (L == 2 && (EN & 1)) dsa_select(lds, QK, MASK, wg, G, wave, lane, tid);
            else if (L == 3 && (EN & 2)) moba_kmean(QK, KM, gw, NGW, lane);
            else sync_after = false;
        } else if (st == 3) {
            if (L == 0 && (EN & 4)) attn_sb(QK, VT, U, lds, wg, G, wave, lane, tid, stg);
            else if (L == 1 && (EN & 8)) attn_dil(QK, VT, U, lds, wg, G, wave, lane, tid, stg);
            else if (L == 2 && (EN & 16)) attn_dsa(QK, VT, MASK, U, lds, wg, G, wave, lane, tid, stg);
            else if (EN & 32) attn_moba(QK, VT, KM, U, lds, wg, G, wave, lane, tid, stg);
        } else if (st == 4 || st == 7 || st == 9) {
            const bf16* A = (st == 4) ? U : (st == 7 ? HID : PB); const bf16* B = (st == 4) ? Wo : (st == 7 ? Wfo : Wp); const int K = (st == 4) ? kout : (st == 7 ? FF : PLE);
            pg8::Gemm g{A, B, T, DM, K}; pg8::StaticOrder S; S.init(T, DM, G, wg);
            EpiB16<0> E{(bf16*)Y, DM};
            pg8::gemm_phase<EpiB16<0>, pg8::StaticOrder, true, true>(lds3, g, S, E);
            if (st == 9) sync_after = false;
        } else if (st == 5 || st == 8) {
            const float* gpost = (st == 5 ? a.g_mix_post : a.g_ffn_post) + L * DM; const float* gnext = (st == 5 ? a.g_ffn_pre : a.g_ple) + L * DM;
            const float* base = (st == 5 && L0 == 0) ? a.x : H;
            for (int r = gw; r < T; r += NGW) {
                norm2_row(base + (size_t)r * DM, (const bf16*)Y + (size_t)r * DM, gpost, gnext, H + (size_t)r * DM, U + (size_t)r * DM, lane);
                if (st == 8) { const f32x4 pv = *(const f32x4*)(a.p + ((size_t)L * T + r) * PLE + lane * 4); u32x2 w; w.x = pk2(pv[0], pv[1]); w.y = pk2(pv[2], pv[3]); *(u32x2*)(PB + (size_t)r * PLE + lane * 4) = w; }
            }
        } else if (st == 6) {
            pg8::Gemm g{U, Wfi, T, FF, DM}; pg8::StaticOrder S; S.init(T, FF, G, wg);
            EpiB16<2> E{HID, FF};
            pg8::gemm_phase<EpiB16<2>, pg8::StaticOrder, true, true>(lds3, g, S, E);
        } else {
            pg8::Gemm g{U, Wg, T, DM, DM}; pg8::StaticOrder S; S.init(T, DM, G, wg);
            EpiGate E{H, (const bf16*)Y, DM};
            pg8::gemm_phase<EpiGate, pg8::StaticOrder, true, true>(lds3, g, S, E);
        }
        if (sync_after && ph + 1 < ph_hi) {
            xcd_barrier(xbar);
        }
#undef a
    }
    {
        const kargp ap = (kargp)apv; const int dump = ap->dump;
        if (dump) {
            asm volatile("s_waitcnt vmcnt(0) lgkmcnt(0)" ::: "memory"); __builtin_amdgcn_fence(__ATOMIC_RELEASE, "agent"); asm volatile("s_waitcnt vmcnt(0) lgkmcnt(0)" ::: "memory");
            grid.sync();
            __builtin_amdgcn_fence(__ATOMIC_ACQUIRE, "agent"); asm volatile("s_waitcnt vmcnt(0) lgkmcnt(0)" ::: "memory");
            unsigned char* ws = ap->ws; float* outp = ap->out;
            const size_t n = (size_t)T * DM;
            for (size_t i = (size_t)blockIdx.x * NTHREADS + threadIdx.x; i < n; i += (size_t)gridDim.x * NTHREADS) {
                float v;
                if (dump == 1) v = bf2f(((const bf16*)(ws + WS_U))[i]);
                else if (dump == 2) v = bf2f(((const bf16*)(ws + WS_QK))[(i >> 10) * 2048 + (i & 1023)]);
                else if (dump == 3) v = bf2f(((const bf16*)(ws + WS_QK))[(i >> 10) * 2048 + 1024 + (i & 1023)]);
                else if (dump == 4) v = bf2f(((const bf16*)(ws + WS_VT))[i]);
                else v = ((const float*)(ws + WS_Y))[i];
                outp[i] = v;
            }
        }
    }
}

extern "C" void kernel_launch(void* const* d_in, const int* in_sizes, int n_in, void* d_out, int out_size, void* d_ws, size_t ws_size, hipStream_t stream) {
    static int grid = 0;
    if (grid == 0) {
        if (n_in != 20 || ws_size < WS_END) { fprintf(stderr, "kernel_launch: unexpected n_in %d or ws_size %zu\n", n_in, ws_size); grid = -1; return; }
        int dev = 0, cus = 0, per_cu = 0;
        hipGetDevice(&dev); hipDeviceGetAttribute(&cus, hipDeviceAttributeMultiprocessorCount, dev);
        hipFuncSetAttribute((const void*)mega, hipFuncAttributeMaxDynamicSharedMemorySize, LDS_BYTES);
        hipOccupancyMaxActiveBlocksPerMultiprocessor(&per_cu, (const void*)mega, NTHREADS, LDS_BYTES);
        if (per_cu < 1) { fprintf(stderr, "kernel_launch: occupancy query says %d blocks per CU\n", per_cu); per_cu = 1; }
        (void)hipGetLastError();
        grid = cus * 1;
    }
    if (grid < 0) return;
    if (hipMemsetAsync(d_ws, 0, 65536, stream) != hipSuccess) { fprintf(stderr, "kernel_launch: hipMemsetAsync of the barrier words failed\n"); return; }
    Args a{};
    a.x = (const float*)d_in[0]; a.p = (const float*)d_in[1]; a.pos = (const int*)d_in[2];
    for (int i = 0; i < 4; ++i) { a.w_in[i] = (const float*)d_in[3 + 2 * i]; a.w_out[i] = (const float*)d_in[4 + 2 * i]; }
    a.g_mix_pre = (const float*)d_in[11]; a.g_mix_post = (const float*)d_in[12]; a.g_ffn_pre = (const float*)d_in[13]; a.g_ffn_post = (const float*)d_in[14];
    a.w_ff_in = (const float*)d_in[15]; a.w_ff_out = (const float*)d_in[16]; a.g_ple = (const float*)d_in[17]; a.w_ple_gate = (const float*)d_in[18]; a.w_ple = (const float*)d_in[19];
    a.out = (float*)d_out; a.ws = (unsigned char*)d_ws; a.lo = 0; a.hi = NPHASE; a.dump = 0; a.lshift = 0;
    void* args[] = {&a};
    hipError_t e = hipLaunchCooperativeKernel((const void*)mega, dim3(grid), dim3(NTHREADS), args, LDS_BYTES, stream);
    if (e != hipSuccess) fprintf(stderr, "kernel_launch: cooperative launch failed: %s (grid %d)\n", hipGetErrorString(e), grid);
}
```

```cpp
#include <hip/hip_runtime.h>
#include <hip/hip_cooperative_groups.h>
#include <cstdio>
#include <cstdint>
namespace pg8 {
#define PG8_LAS __attribute__((address_space(3)))
typedef unsigned short bf16_t;
typedef short bf16x8 __attribute__((ext_vector_type(8)));
typedef float f32x4 __attribute__((ext_vector_type(4)));
typedef unsigned u32x4 __attribute__((ext_vector_type(4)));
constexpr int BM = 256, BK = 64, HALF = 128, HTB = HALF * BK * 2  , STAGE_BYTES = 8 * HTB, NXCD = 8, WGM = 8;

__host__ __device__ __forceinline__ int lds_byte(int r, int c) { const int st = (r >> 4) * 2 + (c >> 5), rr = r & 15, cc = c & 31, ob = rr * 64 + cc * 2; return st * 1024 + (ob ^ (((ob >> 9) & 1) << 5)); }
__host__ __device__ __forceinline__ void stage_rc(int b, int& R, int& C) { const int st = b / 1024, sb = b % 1024, swz = sb ^ (((sb >> 9) & 1) << 5); R = (st >> 1) * 16 + swz / 64; C = (st & 1) * 32 + (swz % 64) / 2; }
__host__ __device__ __forceinline__ int perm32(int rho) { const int n = rho >> 4, i = rho & 15; return 8 * (i >> 2) + 4 * n + (i & 3); }

struct Unit { int pm, pn; };
struct Gemm { const bf16_t* A; const bf16_t* Bt; int M, N, K; };

struct StaticOrder {
    int nM, nN, nwg, G, c;
    __host__ __device__ void init(int M, int N, int G_, int c_) { nM = M / BM; nN = N / BM; nwg = nM * nN; G = G_; c = c_; }
    __host__ __device__ bool next(int i, Unit& u) const {
        const long L = (long)i * G + c; if (L >= nwg) return false;
        int wgid = (int)L; { const int q = nwg / NXCD, r = nwg % NXCD, xcd = wgid % NXCD, off = wgid / NXCD; wgid = (xcd < r ? xcd * (q + 1) : r * (q + 1) + (xcd - r) * q) + off; }
        const int nig = WGM * nN, gid = wgid / nig, fm = gid * WGM, gsz = (nM - fm) < WGM ? (nM - fm) : WGM;
        u.pm = fm + ((wgid % nig) % gsz); u.pn = (wgid % nig) / gsz; return true;
    }
    __device__ __forceinline__ void a_ready(const Unit&) const {}
    __device__ __forceinline__ void done(const Unit&) const {}
};

__device__ __forceinline__ unsigned cvt_pk_bf16(float lo, float hi) { unsigned r; asm volatile("v_cvt_pk_bf16_f32 %0, %1, %2" : "=v"(r) : "v"(lo), "v"(hi)); return r; }
typedef float f32x2 __attribute__((ext_vector_type(2)));
__device__ __forceinline__ f32x2 gelu_pk(f32x2 v) {
    const f32x2 av = __builtin_elementwise_abs(v), d = av * 0.2316418882f + 1.0f;
    f32x2 t; t.x = __builtin_amdgcn_rcpf(d.x); t.y = __builtin_amdgcn_rcpf(d.y);
    f32x2 q = t * 0.5307027145f + (-0.7265760135f); q = q * t + 0.7107068705f; q = q * t + (-0.142248368f); q = q * t + 0.127414796f; q = q * t;
    const f32x2 s = (v * v) * (-0.72134752044f);
    f32x2 e; e.x = __builtin_amdgcn_exp2f(s.x); e.y = __builtin_amdgcn_exp2f(s.y);
    const f32x2 m = v * (q * e), r = v - m;
    f32x2 o; o.x = v.x < 0.f ? m.x : r.x; o.y = v.y < 0.f ? m.y : r.y; return o;
}

template <int ACT  > struct EpiBf16 {
    static constexpr bool PERM = true, AFTER_DRAIN = false; static_assert(ACT == 0 || ACT == 1, "EpiBf16: ACT is 0 (none) or 1 (gelu_pk)");
    bf16_t* O; int ldc; const float* bias; int split_cols; size_t split_stride; float scale0;
    __device__ __forceinline__ void operator()(const f32x4 (&acc)[2][2][4][2], const Unit& u, int wr, int wc, int fr, int fq) const {
        const int row0 = u.pm * BM + wr * 64 + fr; int colt = u.pn * BM; bf16_t* base = O;
        float sc = 1.f; if (split_cols) { const int t = colt / split_cols; base += (size_t)t * split_stride; colt -= t * split_cols; if (t == 0) sc = scale0; }
        const int col0 = colt + wc * 32 + 8 * fq, bcol0 = u.pn * BM + wc * 32 + 8 * fq;
        f32x4 bv[2][2];
#pragma unroll
        for (int bj = 0; bj < 2; ++bj)
#pragma unroll
            for (int n = 0; n < 2; ++n) bv[bj][n] = bias ? *(const f32x4*)(bias + bcol0 + bj * HALF + 4 * n) : (f32x4){0.f, 0.f, 0.f, 0.f};
#pragma unroll
        for (int ai = 0; ai < 2; ++ai)
#pragma unroll
            for (int m = 0; m < 4; ++m) { bf16_t* rowp = base + (size_t)(row0 + ai * HALF + m * 16) * ldc + col0;
#pragma unroll
                for (int bj = 0; bj < 2; ++bj) { f32x4 v0 = acc[ai][bj][m][0] + bv[bj][0], v1 = acc[ai][bj][m][1] + bv[bj][1];
                    if (ACT == 1) { f32x2 a = gelu_pk((f32x2){v0[0], v0[1]}), b = gelu_pk((f32x2){v0[2], v0[3]}), c = gelu_pk((f32x2){v1[0], v1[1]}), d = gelu_pk((f32x2){v1[2], v1[3]});
                        v0 = (f32x4){a.x, a.y, b.x, b.y}; v1 = (f32x4){c.x, c.y, d.x, d.y}; }
                    v0 = v0 * sc; v1 = v1 * sc; u32x4 w; w.x = cvt_pk_bf16(v0[0], v0[1]); w.y = cvt_pk_bf16(v0[2], v0[3]); w.z = cvt_pk_bf16(v1[0], v1[1]); w.w = cvt_pk_bf16(v1[2], v1[3]);
                    *(u32x4*)(rowp + bj * HALF) = w; } }
    }
};
template <class Epi, class Sched, bool ALIGN_EPI = false, bool SP2 = false>
__device__ __forceinline__ void gemm_phase(PG8_LAS unsigned char* lds, const Gemm g, const Sched& S, const Epi& E) {
    int tid_ = threadIdx.x; asm volatile("" : "+v"(tid_));
    const int tid = tid_, wid = __builtin_amdgcn_readfirstlane(tid >> 6), lane = tid & 63, wr = wid >> 2, wc = wid & 3, fr = lane & 15, fq = lane >> 4;
    const int K = g.K, nt = K / BK;
    unsigned voffA[2], voffB[2];
#pragma unroll
    for (int i = 0; i < 2; ++i) { int R, C; stage_rc(tid * 16 + i * 8192, R, C); const int Rb = Epi::PERM ? ((R & ~31) + perm32(R & 31)) : R;
        voffA[i] = (unsigned)(R * K + C) * 2u; voffB[i] = (unsigned)(Rb * K + C) * 2u; }
    const size_t kstep = (size_t)(BK * 2);
    const size_t hstep = (size_t)HALF * K * 2;
    const size_t tstep = 2 * hstep;
    const unsigned ldsw = (unsigned)wid * 1024u;
    const int aoff = lds_byte(wr * 64 + fr, fq * 8), boff = lds_byte(wc * 32 + fr, fq * 8);
#define PG8_SA(b, h) (((b) * 2 + (h)) * HTB)
#define PG8_SB(b, h) ((4 + (b) * 2 + (h)) * HTB)
#define PG8_STAGE(bufoff, gbase, voff) do { _Pragma("unroll") for (int _i = 0; _i < 2; ++_i) \
        __builtin_amdgcn_global_load_lds((const unsigned*)((const char*)(gbase) + (voff)[_i]), (PG8_LAS unsigned*)(lds + (bufoff) + ldsw + _i * 8192), 16, 0, 0); } while (0)
#define PG8_LDA(dst, b, h) do { _Pragma("unroll") for (int m = 0; m < 4; ++m) _Pragma("unroll") for (int k = 0; k < 2; ++k) dst[m][k] = *(const PG8_LAS bf16x8*)(lds + PG8_SA(b, h) + aoff + m * 2048 + k * 1024); } while (0)
#define PG8_LDB(dst, b, h) do { _Pragma("unroll") for (int n = 0; n < 2; ++n) _Pragma("unroll") for (int k = 0; k < 2; ++k) dst[n][k] = *(const PG8_LAS bf16x8*)(lds + PG8_SB(b, h) + boff + n * 2048 + k * 1024); } while (0)
#define PG8_MMA(ai, bj, At, Bt) do { __builtin_amdgcn_s_setprio(1); _Pragma("unroll") for (int m = 0; m < 4; ++m) _Pragma("unroll") for (int n = 0; n < 2; ++n) _Pragma("unroll") for (int k = 0; k < 2; ++k) \
        acc[ai][bj][m][n] = __builtin_amdgcn_mfma_f32_16x16x32_bf16(Bt[n][k], At[m][k], acc[ai][bj][m][n], 0, 0, 0); __builtin_amdgcn_s_setprio(0); } while (0)
#define PG8_WAIT_V(n) asm volatile("s_waitcnt vmcnt(" #n ")" ::: "memory")
#define PG8_WAIT_L(n) asm volatile("s_waitcnt lgkmcnt(" #n ")" ::: "memory")
#define PG8_BAR __builtin_amdgcn_s_barrier()
#define PG8_SCHED __builtin_amdgcn_sched_barrier(0)
    Unit cur, nxt; int ui = 0;
    if (!S.next(0, cur)) return;
    f32x4 acc[2][2][4][2];
#pragma unroll
    for (int a = 0; a < 2; ++a)
#pragma unroll
        for (int b = 0; b < 2; ++b)
#pragma unroll
            for (int m = 0; m < 4; ++m)
#pragma unroll
                for (int n = 0; n < 2; ++n) acc[a][b][m][n] = (f32x4){0.f, 0.f, 0.f, 0.f};
    bf16x8 At[4][2], B0[2][2], B1[2][2];
    const char* cA = (const char*)g.A + (size_t)cur.pm * tstep; const char* cB = (const char*)g.Bt + (size_t)cur.pn * tstep;
    S.a_ready(cur);
    if constexpr (SP2) {
        PG8_STAGE(PG8_SB(0, 0), cB, voffB); PG8_STAGE(PG8_SB(0, 1), cB + hstep, voffB); PG8_STAGE(PG8_SA(0, 0), cA, voffA); PG8_STAGE(PG8_SA(0, 1), cA + hstep, voffA);
        if (wr == 1) PG8_BAR;
        PG8_WAIT_V(2); PG8_BAR;
        PG8_STAGE(PG8_SB(1, 0), cB + kstep, voffB); PG8_STAGE(PG8_SA(1, 0), cA + kstep, voffA); PG8_STAGE(PG8_SB(1, 1), cB + hstep + kstep, voffB);
        PG8_WAIT_V(6); PG8_BAR;
    } else {
        PG8_STAGE(PG8_SB(0, 0), cB, voffB); PG8_STAGE(PG8_SA(0, 0), cA, voffA); PG8_STAGE(PG8_SB(0, 1), cB + hstep, voffB); PG8_STAGE(PG8_SA(0, 1), cA + hstep, voffA);
        if (wr == 1) PG8_BAR;
        PG8_WAIT_V(4); PG8_BAR;
        PG8_STAGE(PG8_SB(1, 0), cB + kstep, voffB); PG8_STAGE(PG8_SA(1, 0), cA + kstep, voffA); PG8_STAGE(PG8_SB(1, 1), cB + hstep + kstep, voffB);
        PG8_WAIT_V(6); PG8_BAR;
    }
    for (;;) {
        const bool has_next = S.next(ui + 1, nxt);
        const char* nA = has_next ? (const char*)g.A + (size_t)nxt.pm * tstep : cA; const char* nB = has_next ? (const char*)g.Bt + (size_t)nxt.pn * tstep : cB;
        for (int t = 0; t < nt; t += 2) {
            const bool last = (t == nt - 2);
            const char* a1 = cA + (size_t)(t + 1) * kstep;
            const char* a2 = last ? nA : cA + (size_t)(t + 2) * kstep; const char* b2 = last ? nB : cB + (size_t)(t + 2) * kstep;
            const char* a3 = a2 + kstep; const char* b3 = b2 + kstep;
            if (last && has_next) S.a_ready(nxt);
            if constexpr (SP2) {
            PG8_LDB(B0, 0, 0); PG8_LDB(B1, 0, 1); PG8_SCHED; PG8_LDA(At, 0, 0); PG8_STAGE(PG8_SA(1, 1), a1 + hstep, voffA);
            PG8_WAIT_V(8); PG8_WAIT_L(0); PG8_BAR; PG8_MMA(0, 0, At, B0); PG8_MMA(0, 1, At, B1); PG8_BAR; PG8_SCHED;
            PG8_LDA(At, 0, 1); PG8_STAGE(PG8_SB(0, 0), b2, voffB); PG8_STAGE(PG8_SB(0, 1), b2 + hstep, voffB); PG8_STAGE(PG8_SA(0, 0), a2, voffA);
            PG8_WAIT_V(8); PG8_WAIT_L(0); PG8_BAR; PG8_MMA(1, 0, At, B0); PG8_MMA(1, 1, At, B1); PG8_BAR; PG8_SCHED;
            PG8_LDB(B0, 1, 0); PG8_LDB(B1, 1, 1); PG8_SCHED; PG8_LDA(At, 1, 0); PG8_STAGE(PG8_SA(0, 1), a2 + hstep, voffA);
            PG8_WAIT_V(8); PG8_WAIT_L(0); PG8_BAR; PG8_MMA(0, 0, At, B0); PG8_MMA(0, 1, At, B1); PG8_BAR; PG8_SCHED;
            PG8_LDA(At, 1, 1); PG8_STAGE(PG8_SB(1, 0), b3, voffB); PG8_STAGE(PG8_SB(1, 1), b3 + hstep, voffB); PG8_STAGE(PG8_SA(1, 0), a3, voffA);
            PG8_WAIT_V(8); PG8_WAIT_L(0); PG8_BAR; PG8_MMA(1, 0, At, B0); PG8_MMA(1, 1, At, B1); PG8_BAR; PG8_SCHED;
            } else {
            PG8_LDB(B0, 0, 0); PG8_SCHED; PG8_LDA(At, 0, 0); PG8_STAGE(PG8_SA(1, 1), a1 + hstep, voffA);
            PG8_WAIT_L(8); PG8_BAR; PG8_WAIT_L(0); PG8_MMA(0, 0, At, B0); PG8_BAR; PG8_SCHED;
            PG8_LDB(B1, 0, 1); PG8_STAGE(PG8_SB(0, 0), b2, voffB);
            PG8_BAR; PG8_WAIT_L(0); PG8_MMA(0, 1, At, B1); PG8_BAR;
            PG8_LDA(At, 0, 1); PG8_STAGE(PG8_SA(0, 0), a2, voffA);
            PG8_BAR; PG8_WAIT_L(0); PG8_MMA(1, 0, At, B0); PG8_BAR; PG8_SCHED;
            PG8_STAGE(PG8_SB(0, 1), b2 + hstep, voffB);
            PG8_WAIT_V(6); PG8_BAR; PG8_MMA(1, 1, At, B1); PG8_BAR;
            PG8_LDB(B0, 1, 0); PG8_SCHED; PG8_LDA(At, 1, 0); PG8_STAGE(PG8_SA(0, 1), a2 + hstep, voffA);
            PG8_WAIT_L(8); PG8_BAR; PG8_WAIT_L(0); PG8_MMA(0, 0, At, B0); PG8_BAR; PG8_SCHED;
            PG8_LDB(B1, 1, 1); PG8_STAGE(PG8_SB(1, 0), b3, voffB);
            PG8_BAR; PG8_WAIT_L(0); PG8_MMA(0, 1, At, B1); PG8_BAR;
            PG8_LDA(At, 1, 1); PG8_STAGE(PG8_SA(1, 0), a3, voffA);
            PG8_BAR; PG8_WAIT_L(0); PG8_MMA(1, 0, At, B0); PG8_BAR; PG8_SCHED;
            PG8_STAGE(PG8_SB(1, 1), b3 + hstep, voffB);
            PG8_WAIT_V(6); PG8_BAR; PG8_MMA(1, 1, At, B1); PG8_BAR;
            }
        }
        if constexpr (ALIGN_EPI) { if (wr == 0) PG8_BAR; }
        if constexpr (!Epi::AFTER_DRAIN) { E(acc, cur, wr, wc, fr, fq); S.done(cur); }
        if (!has_next) break;
#pragma unroll
        for (int a = 0; a < 2; ++a)
#pragma unroll
            for (int b = 0; b < 2; ++b)
#pragma unroll
                for (int m = 0; m < 4; ++m)
#pragma unroll
                    for (int n = 0; n < 2; ++n) acc[a][b][m][n] = (f32x4){0.f, 0.f, 0.f, 0.f};
        cur = nxt; cA = nA; cB = nB; ++ui;
        if constexpr (ALIGN_EPI) { if (wr == 1) PG8_BAR; }
    }
    PG8_WAIT_V(0);
    if constexpr (!ALIGN_EPI) { if (wr == 0) PG8_BAR; }
    PG8_BAR;
    if constexpr (Epi::AFTER_DRAIN) { E.fused(acc, cur, wr, wc, fr, fq, lds, wid, lane); S.done(cur); }
#undef PG8_SA
#undef PG8_SB
#undef PG8_STAGE
#undef PG8_LDA
#undef PG8_LDB
#undef PG8_MMA
#undef PG8_WAIT_V
#undef PG8_WAIT_L
#undef PG8_BAR
#undef PG8_SCHED
}
}

namespace cg = cooperative_groups;
#define LAS __attribute__((address_space(3)))
typedef unsigned short bf16;
typedef short bf16x8 __attribute__((ext_vector_type(8)));
typedef short s16x4 __attribute__((ext_vector_type(4)));
typedef float f32x4 __attribute__((ext_vector_type(4)));
typedef float f32x16 __attribute__((ext_vector_type(16)));
typedef unsigned u32x4 __attribute__((ext_vector_type(4)));
typedef unsigned u32x2 __attribute__((ext_vector_type(2)));

constexpr int SEQ = 8192, T = 16384, DM = 1024, FF = 4096, PLE = 256;
constexpr float EPS = 1e-6f;
constexpr size_t MiB = 1u << 20;
constexpr size_t WS_ROPE = 1 * MiB;
constexpr size_t WS_KMEAN = 2 * MiB;
constexpr size_t WS_W = 4 * MiB;
constexpr size_t W_QK = 0, W_V = 6 * MiB, W_OUT = 9 * MiB, W_FI = 11 * MiB, W_FO = 19 * MiB, W_G = 27 * MiB, W_P = 29 * MiB;
constexpr size_t WS_U = 36 * MiB;
constexpr size_t WS_QK = 68 * MiB;
constexpr size_t WS_VT = 164 * MiB;
constexpr size_t WS_HID = 68 * MiB;
constexpr size_t WS_Y = 212 * MiB;
constexpr size_t WS_PB = 276 * MiB;
constexpr size_t WS_END = 284 * MiB;
constexpr int LDS_BYTES = 147456;
constexpr int NTHREADS = 512;

struct Args {
    const float* x; const float* p; const int* pos;
    const float* w_in[4]; const float* w_out[4];
    const float *g_mix_pre, *g_mix_post, *g_ffn_pre, *g_ffn_post, *w_ff_in, *w_ff_out, *g_ple, *w_ple_gate, *w_ple;
    float* out; unsigned char* ws;
    int lo, hi, dump, lshift;
};

__device__ __forceinline__ float bf2f(unsigned short b) { return __uint_as_float((unsigned)b << 16); }
typedef float f32x2_t __attribute__((ext_vector_type(2))); typedef __bf16 bf16x2_t __attribute__((ext_vector_type(2)));
__device__ __forceinline__ unsigned pk2(float lo, float hi) { f32x2_t v = {lo, hi}; bf16x2_t b = __builtin_convertvector(v, bf16x2_t); return __builtin_bit_cast(unsigned, b); }
__device__ __forceinline__ float wave_sum(float v) {
#pragma unroll
    for (int o = 1; o < 64; o <<= 1) v += __shfl_xor(v, o);
    return v;
}
__device__ __forceinline__ float ex2(float x) { return __builtin_amdgcn_exp2f(x); }
__device__ __forceinline__ float lg2(float x) { return __builtin_amdgcn_logf(x); }

struct EpiF32 {
    static constexpr bool PERM = false, AFTER_DRAIN = false;
    float* O; int ldc;
    __device__ __forceinline__ void operator()(const pg8::f32x4 (&acc)[2][2][4][2], const pg8::Unit& u, int wr, int wc, int fr, int fq) const {
        const int row0 = u.pm * 256 + wr * 64 + fr, col0 = u.pn * 256 + wc * 32 + 4 * fq;
#pragma unroll
        for (int ai = 0; ai < 2; ++ai)
#pragma unroll
            for (int m = 0; m < 4; ++m) { float* rp = O + (size_t)(row0 + ai * 128 + m * 16) * ldc + col0;
#pragma unroll
                for (int bj = 0; bj < 2; ++bj)
#pragma unroll
                    for (int n = 0; n < 2; ++n) *(pg8::f32x4*)(rp + bj * 128 + n * 16) = acc[ai][bj][m][n]; }
    }
};
struct EpiGate {
    static constexpr bool PERM = true, AFTER_DRAIN = false;
    float* H; const bf16* PL; int ldc;
    __device__ __forceinline__ void operator()(const pg8::f32x4 (&acc)[2][2][4][2], const pg8::Unit& u, int wr, int wc, int fr, int fq) const {
        const int row0 = u.pm * 256 + wr * 64 + fr, col0 = u.pn * 256 + wc * 32 + 8 * fq;
#pragma unroll
        for (int ai = 0; ai < 2; ++ai)
#pragma unroll
            for (int m = 0; m < 4; ++m) { const size_t off = (size_t)(row0 + ai * 128 + m * 16) * ldc + col0;
#pragma unroll
                for (int bj = 0; bj < 2; ++bj) { const size_t o2 = off + bj * 128;
                    const u32x4 pw = *(const u32x4*)(PL + o2);
#pragma unroll
                    for (int n = 0; n < 2; ++n) { const pg8::f32x4 a = acc[ai][bj][m][n], hv = *(const pg8::f32x4*)(H + o2 + 4 * n); pg8::f32x4 r;
                        const unsigned w0 = n ? pw.z : pw.x, w1 = n ? pw.w : pw.y;
                        const float pl[4] = {__uint_as_float(w0 << 16), __uint_as_float(w0 & 0xffff0000u), __uint_as_float(w1 << 16), __uint_as_float(w1 & 0xffff0000u)};
#pragma unroll
                        for (int c = 0; c < 4; ++c) { const float g = 1.0f / (1.0f + __expf(-a[c])); r[c] = hv[c] + pl[c] * g; }
                        *(pg8::f32x4*)(H + o2 + 4 * n) = r; } } }
    }
};
template <int ACT  > struct EpiB16 {
    static constexpr bool PERM = true, AFTER_DRAIN = false;
    bf16* O; int ldc;
    __device__ __forceinline__ void operator()(const pg8::f32x4 (&acc)[2][2][4][2], const pg8::Unit& u, int wr, int wc, int fr, int fq) const {
        const int row0 = u.pm * 256 + wr * 64 + fr, col0 = u.pn * 256 + wc * 32 + 8 * fq;
#pragma unroll
        for (int ai = 0; ai < 2; ++ai)
#pragma unroll
            for (int m = 0; m < 4; ++m) { bf16* rp = O + (size_t)(row0 + ai * 128 + m * 16) * ldc + col0;
#pragma unroll
                for (int bj = 0; bj < 2; ++bj) { pg8::f32x4 v0 = acc[ai][bj][m][0], v1 = acc[ai][bj][m][1];
                    if (ACT == 2) {
#pragma unroll
                        for (int c = 0; c < 4; ++c) { const float a = fmaxf(v0[c], 0.f), b = fmaxf(v1[c], 0.f); v0[c] = a * a; v1[c] = b * b; } }
                    u32x4 w; w.x = pk2(v0[0], v0[1]); w.y = pk2(v0[2], v0[3]); w.z = pk2(v1[0], v1[1]); w.w = pk2(v1[2], v1[3]);
                    *(u32x4*)(rp + bj * 128) = w; } }
    }
};
struct EpiQK {
    static constexpr bool PERM = true, AFTER_DRAIN = false;
    bf16* O; int ldc; const float* cs; const float* sn; int rope_chunks;
    __device__ __forceinline__ void operator()(const pg8::f32x4 (&acc)[2][2][4][2], const pg8::Unit& u, int wr, int wc, int fr, int fq) const {
        const int row0 = u.pm * 256 + wr * 64 + fr, colw = u.pn * 256 + wc * 32;
        const bool ropew = ((wc & 1) == 0);
        const float sgn = (fq == 0) ? -1.f : 1.f;
#pragma unroll
        for (int ai = 0; ai < 2; ++ai)
#pragma unroll
            for (int m = 0; m < 4; ++m) { const int row = row0 + ai * 128 + m * 16; bf16* rp = O + (size_t)row * ldc + colw + 8 * fq;
#pragma unroll
                for (int bj = 0; bj < 2; ++bj) { pg8::f32x4 v0 = acc[ai][bj][m][0], v1 = acc[ai][bj][m][1];
                    const int c64 = (colw + bj * 128) >> 6;
                    if (ropew && c64 < rope_chunks) {
                        const pg8::f32x4 c0 = *(const pg8::f32x4*)(cs + row * 8), c1 = *(const pg8::f32x4*)(cs + row * 8 + 4);
                        const pg8::f32x4 s0 = *(const pg8::f32x4*)(sn + row * 8), s1 = *(const pg8::f32x4*)(sn + row * 8 + 4);
                        pg8::f32x4 o0, o1;
#pragma unroll
                        for (int c = 0; c < 4; ++c) { o0[c] = __shfl_xor(v0[c], 16); o1[c] = __shfl_xor(v1[c], 16); }
                        if (fq < 2) {
#pragma unroll
                            for (int c = 0; c < 4; ++c) { v0[c] = v0[c] * c0[c] + sgn * o0[c] * s0[c]; v1[c] = v1[c] * c1[c] + sgn * o1[c] * s1[c]; } }
                    }
                    u32x4 w; w.x = pk2(v0[0], v0[1]); w.y = pk2(v0[2], v0[3]); w.z = pk2(v1[0], v1[1]); w.w = pk2(v1[2], v1[3]);
                    *(u32x4*)(rp + bj * 128) = w; } }
    }
};

__device__ __forceinline__ void tr_item(const float* __restrict__ W, int N, int K, int c0, int nc, bf16* WT, int r0, float* scr, int item, int nblk, int lane) {
    const int kb = item / nblk, nb = item % nblk, k0 = 64 * kb, n0 = 32 * nb;
    const int n4 = (lane & 7) * 4, col = n0 + n4;
#pragma unroll
    for (int i = 0; i < 8; ++i) { const int kk = 8 * i + (lane >> 3);
        const f32x4 v = (col < nc) ? *(const f32x4*)(W + (size_t)(k0 + kk) * N + c0 + col) : (f32x4){0.f, 0.f, 0.f, 0.f};
        scr[kk * 33 + n4] = v[0]; scr[kk * 33 + n4 + 1] = v[1]; scr[kk * 33 + n4 + 2] = v[2]; scr[kk * 33 + n4 + 3] = v[3]; }
    asm volatile("s_waitcnt lgkmcnt(0)" ::: "memory");
    const int c = lane & 7;
#pragma unroll
    for (int j = 0; j < 4; ++j) { const int n = (lane >> 3) + 8 * j; const float* s = scr + (8 * c) * 33 + n;
        u32x4 o; o.x = pk2(s[0 * 33], s[1 * 33]); o.y = pk2(s[2 * 33], s[3 * 33]); o.z = pk2(s[4 * 33], s[5 * 33]); o.w = pk2(s[6 * 33], s[7 * 33]);
        *(u32x4*)(WT + (size_t)(r0 + n0 + n) * K + k0 + 8 * c) = o; }
    asm volatile("s_waitcnt lgkmcnt(0)" ::: "memory");
}
__device__ __forceinline__ void tr_seg(const float* W, int N, int K, int c0, int nc, int ncpad, bf16* WT, int r0, float* scr, int gw, int NGW, int lane, int& off) {
    const int nblk = ncpad / 32, nitems = (K / 256) * nblk;
    int first = gw - off; if (first < 0) first += NGW;
    off += nitems; while (off >= NGW) off -= NGW;
    for (int it = first; it < nitems; it += NGW) { const int kb4 = it / nblk, nb = it % nblk;
#pragma unroll 1
        for (int kk = 0; kk < 4; ++kk) tr_item(W, N, K, c0, nc, WT, r0, scr, (kb4 * 4 + kk) * nblk + nb, nblk, lane); }
}

__device__ __forceinline__ void store_u(bf16* urow, const f32x4 (&v)[4], float r, const float* g, int lane) {
#pragma unroll
    for (int j = 0; j < 4; ++j) { const f32x4 gg = *(const f32x4*)(g + lane * 4 + 256 * j);
        u32x2 w; w.x = pk2(v[j][0] * r * gg[0], v[j][1] * r * gg[1]); w.y = pk2(v[j][2] * r * gg[2], v[j][3] * r * gg[3]);
        *(u32x2*)(urow + lane * 4 + 256 * j) = w; }
}
__device__ __forceinline__ void norm1_row(const float* hrow, const float* g, bf16* urow, int lane) {
    f32x4 v[4]; float ss = 0.f;
#pragma unroll
    for (int j = 0; j < 4; ++j) { v[j] = *(const f32x4*)(hrow + lane * 4 + 256 * j); ss += v[j][0] * v[j][0] + v[j][1] * v[j][1] + v[j][2] * v[j][2] + v[j][3] * v[j][3]; }
    const float r = rsqrtf(wave_sum(ss) * (1.f / DM) + EPS);
    store_u(urow, v, r, g, lane);
}
__device__ __forceinline__ void norm2_row(const float* base, const bf16* yrow, const float* gpost, const float* gnext, float* hout, bf16* urow, int lane) {
    f32x4 y[4], h[4]; float ss = 0.f;
#pragma unroll
    for (int j = 0; j < 4; ++j) { const u32x2 yw = *(const u32x2*)(yrow + lane * 4 + 256 * j); y[j] = (f32x4){__uint_as_float(yw.x << 16), __uint_as_float(yw.x & 0xffff0000u), __uint_as_float(yw.y << 16), __uint_as_float(yw.y & 0xffff0000u)}; h[j] = *(const f32x4*)(base + lane * 4 + 256 * j);
        ss += y[j][0] * y[j][0] + y[j][1] * y[j][1] + y[j][2] * y[j][2] + y[j][3] * y[j][3]; }
    const float ry = rsqrtf(wave_sum(ss) * (1.f / DM) + EPS);
    float s2 = 0.f;
#pragma unroll
    for (int j = 0; j < 4; ++j) { const f32x4 gg = *(const f32x4*)(gpost + lane * 4 + 256 * j);
#pragma unroll
        for (int c = 0; c < 4; ++c) { h[j][c] = h[j][c] + y[j][c] * ry * gg[c]; s2 += h[j][c] * h[j][c]; }
        *(f32x4*)(hout + lane * 4 + 256 * j) = h[j]; }
    const float rh = rsqrtf(wave_sum(s2) * (1.f / DM) + EPS);
    store_u(urow, h, rh, gnext, lane);
}

__device__ __forceinline__ int crow(int r, int hi) { return (r & 3) + 8 * (r >> 2) + 4 * hi; }
__device__ __forceinline__ void ld_frags(bf16x8 (&f)[4], const bf16* p) {
#pragma unroll
    for (int d0 = 0; d0 < 4; ++d0) f[d0] = *(const bf16x8*)(p + 16 * d0);
}
__device__ __forceinline__ f32x16 qk_tile(const bf16x8 (&kf)[4], const bf16x8 (&qf)[4]) {
    f32x16 s = {};
#pragma unroll
    for (int d0 = 0; d0 < 4; ++d0) s = __builtin_amdgcn_mfma_f32_32x32x16_bf16(kf[d0], qf[d0], s, 0, 0, 0);
    asm volatile("" : "+v"(s) : "v"(kf[0]), "v"(kf[1]), "v"(kf[2]), "v"(kf[3]), "v"(qf[0]), "v"(qf[1]), "v"(qf[2]), "v"(qf[3]));
    return s;
}
__device__ __forceinline__ void ld_vt(bf16x8 (&vf)[2][2], const bf16* vp) {
#pragma unroll
    for (int db = 0; db < 2; ++db)
#pragma unroll
        for (int s = 0; s < 2; ++s) { const bf16* q = vp + (size_t)db * 32 * T + 16 * s; const s16x4 a = *(const s16x4*)q, b = *(const s16x4*)(q + 8);
            vf[db][s] = (bf16x8){a[0], a[1], a[2], a[3], b[0], b[1], b[2], b[3]}; }
}
__device__ __forceinline__ void pv_acc(f32x16 (&o)[2], const bf16x8 (&vf)[2][2], const f32x16& p) {
#pragma unroll
    for (int s = 0; s < 2; ++s) { u32x4 w; w.x = pk2(p[8 * s], p[8 * s + 1]); w.y = pk2(p[8 * s + 2], p[8 * s + 3]); w.z = pk2(p[8 * s + 4], p[8 * s + 5]); w.w = pk2(p[8 * s + 6], p[8 * s + 7]);
        const bf16x8 pf = __builtin_bit_cast(bf16x8, w);
#pragma unroll
        for (int db = 0; db < 2; ++db) o[db] = __builtin_amdgcn_mfma_f32_32x32x16_bf16(vf[db][s], pf, o[db], 0, 0, 0); }
}
struct KV { bf16x8 k[4]; bf16x8 v[2][2]; };
__device__ __forceinline__ void ld_kv(KV& x, const bf16* kp, const bf16* vp) { ld_frags(x.k, kp); ld_vt(x.v, vp); }
constexpr float SC2 = 0.125f * 1.4426950408889634f;
__device__ __forceinline__ void sm_step(f32x16 s, unsigned am, int hi, float& m, float& l, f32x16 (&o)[2], const bf16x8 (&vf)[2][2]) {
    const unsigned am2 = am >> (4 * hi);
    float mx = -INFINITY;
#pragma unroll
    for (int r = 0; r < 16; ++r) { const bool ok = (am2 >> ((r & 3) + 8 * (r >> 2))) & 1u; s[r] = ok ? s[r] * SC2 : -INFINITY; mx = fmaxf(mx, s[r]); }
    mx = fmaxf(mx, __shfl_xor(mx, 32));
    const float mn = fmaxf(m, mx), ms = (mn == -INFINITY) ? 0.f : mn;
    const float alpha = ex2(m - ms);
    float sum = 0.f;
#pragma unroll
    for (int r = 0; r < 16; ++r) { s[r] = ex2(s[r] - ms); sum += s[r]; }
    l = l * alpha + sum; m = mn;
#pragma unroll
    for (int db = 0; db < 2; ++db)
#pragma unroll
        for (int r = 0; r < 16; ++r) o[db][r] *= alpha;
    pv_acc(o, vf, s);
}
__device__ __forceinline__ void sm_step64(f32x16 s0, f32x16 s1, unsigned am0, unsigned am1, int hi, float& m, float& l, f32x16 (&o)[2], const bf16x8 (&v0)[2][2], const bf16x8 (&v1)[2][2]) {
    const unsigned a0 = am0 >> (4 * hi), a1 = am1 >> (4 * hi);
    float mx = -INFINITY;
#pragma unroll
    for (int r = 0; r < 16; ++r) { const int bit = (r & 3) + 8 * (r >> 2);
        s0[r] = ((a0 >> bit) & 1u) ? s0[r] : -INFINITY; s1[r] = ((a1 >> bit) & 1u) ? s1[r] : -INFINITY; mx = fmaxf(mx, fmaxf(s0[r], s1[r])); }
    mx *= SC2;
    mx = fmaxf(mx, __shfl_xor(mx, 32));
    const float mn = fmaxf(m, mx), ms = (mn == -INFINITY) ? 0.f : mn;
    const float alpha = ex2(m - ms);
    float sum = 0.f;
#pragma unroll
    for (int r = 0; r < 16; ++r) { s0[r] = ex2(__builtin_fmaf(s0[r], SC2, -ms)); s1[r] = ex2(__builtin_fmaf(s1[r], SC2, -ms)); sum += s0[r] + s1[r]; }
    l = l * alpha + sum; m = mn;
#pragma unroll
    for (int db = 0; db < 2; ++db)
#pragma unroll
        for (int r = 0; r < 16; ++r) o[db][r] *= alpha;
    pv_acc(o, v0, s0);
    pv_acc(o, v1, s1);
}
__device__ __forceinline__ void write_o(bf16* obase, int ldo, f32x16 (&o)[2], float inv, int lane, bf16* stg) {
    const int r32 = lane & 31, hi = lane >> 5;
#pragma unroll
    for (int db = 0; db < 2; ++db)
#pragma unroll
        for (int g = 0; g < 4; ++g) { u32x2 w; w.x = pk2(o[db][4 * g] * inv, o[db][4 * g + 1] * inv); w.y = pk2(o[db][4 * g + 2] * inv, o[db][4 * g + 3] * inv);
            *(u32x2*)(stg + r32 * 72 + 32 * db + 8 * g + 4 * hi) = w; }
    asm volatile("s_waitcnt lgkmcnt(0)" ::: "memory");
#pragma unroll
    for (int i = 0; i < 4; ++i) { const int row = i * 8 + (lane >> 3), ch = lane & 7; const u32x4 v = *(const u32x4*)(stg + row * 72 + ch * 8); *(u32x4*)(obase + (size_t)row * ldo + ch * 8) = v; }
    asm volatile("s_waitcnt lgkmcnt(0)" ::: "memory");
}
__device__ __forceinline__ unsigned causal_bits(int t, int key0) { const int d = t - key0; return d >= 31 ? 0xffffffffu : (d < 0 ? 0u : ((2u << d) - 1u)); }
__device__ __forceinline__ unsigned lower_bits(int lo, int key0) { const int d = lo - key0; return d <= 0 ? 0xffffffffu : (d >= 32 ? 0u : (0xffffffffu << d)); }
constexpr int KV_OFF = 40960, KV_BUF = 18432, KV_VOFF = 9216;
struct KVLD { u32x4 k, v; };
__device__ __forceinline__ KVLD kv_issue(const bf16* Kb, int ldk, const bf16* Vb, int key0, int tid) {
    KVLD x; x.k = *(const u32x4*)(Kb + (size_t)(key0 + (tid >> 3)) * ldk + (tid & 7) * 8);
    x.v = *(const u32x4*)(Vb + (size_t)(tid >> 3) * T + key0 + (tid & 7) * 8); return x;
}
__device__ __forceinline__ void kv_store(unsigned char* buf, const KVLD& x, int tid) {
    *(u32x4*)(buf + (tid >> 3) * 144 + (tid & 7) * 16) = x.k;
    *(u32x4*)(buf + KV_VOFF + (tid >> 3) * 144 + (tid & 7) * 16) = x.v;
}
__device__ __forceinline__ void kv_frags(KV& x, const unsigned char* buf, int sub, int r32, int hi) {
#pragma unroll
    for (int d0 = 0; d0 < 4; ++d0) x.k[d0] = *(const bf16x8*)(buf + (32 * sub + r32) * 144 + 32 * d0 + 16 * hi);
#pragma unroll
    for (int db = 0; db < 2; ++db)
#pragma unroll
        for (int ss = 0; ss < 2; ++ss) { const unsigned char* q = buf + KV_VOFF + (32 * db + r32) * 144 + 64 * sub + 32 * ss + 8 * hi; const s16x4 va = *(const s16x4*)q, vb = *(const s16x4*)(q + 16);
            x.v[db][ss] = (bf16x8){va[0], va[1], va[2], va[3], vb[0], vb[1], vb[2], vb[3]}; }
}
__device__ __forceinline__ bool grp_unit(int i, int wg, int G, int nbh, int& bh, int& grp) {
    if (G == 256 && nbh == 32) { if (i >= 4) return false; const int j = wg >> 3, s = j >> 2; bh = (wg & 7) * 4 + (j & 3); grp = (i == 0) ? s : (i == 1) ? 15 - s : (i == 2) ? 16 + s : 31 - s; return true; }
    if (G == 256 && nbh == 16) { if (i >= 2) return false; const int j = wg >> 3, s = j >> 1; bh = (wg & 7) * 2 + (j & 1); grp = (i == 0) ? s : 31 - s; return true; }
    const int u = wg + i * G; if (u >= nbh * 32) return false; bh = u >> 5; grp = u & 31; return true;
}

__device__ __forceinline__ void sb_step(f32x16 s, int t, int key0, int hi, float& R, f32x16 (&o)[2], const bf16x8 (&vf)[2][2]) {
    float lf[16], ls[16]; bool ok[16];
#pragma unroll
    for (int r = 0; r < 16; ++r) { const int key = key0 + crow(r, hi); ok[r] = key < t; const float z2 = s[r] * SC2;
        const float sp = fmaxf(z2, 0.f) + lg2(1.f + ex2(-fabsf(z2))); lf[r] = ok[r] ? -sp : 0.f; ls[r] = z2 - sp; }
    float Gs[4], PG[4];
#pragma unroll
    for (int g = 0; g < 4; ++g) { Gs[g] = (lf[4 * g] + lf[4 * g + 1]) + (lf[4 * g + 2] + lf[4 * g + 3]); PG[g] = __shfl_xor(Gs[g], 32); }
    float run = R;
#pragma unroll
    for (int g = 3; g >= 0; --g) { float acc = run + (hi == 0 ? PG[g] : 0.f);
#pragma unroll
        for (int ii = 3; ii >= 0; --ii) { const int r = 4 * g + ii; s[r] = ok[r] ? ex2(ls[r] + acc) : 0.f; acc += lf[r]; }
        run += Gs[g] + PG[g]; }
    R = run;
    pv_acc(o, vf, s);
}
__device__ __forceinline__ void attn_sb(const bf16* __restrict__ QK, const bf16* __restrict__ VT, bf16* O, unsigned char* lds, int wg, int G, int wave, int lane, int tid, bf16* stg) {
    const int r32 = lane & 31, hi = lane >> 5;
    unsigned* flag = (unsigned*)(lds + KV_OFF + 2 * KV_BUF);
    int bh, grp;
    for (int i = 0; grp_unit(i, wg, G, 32, bh, grp); ++i) {
        const int b = bh >> 4, h = bh & 15, tile = grp * 8 + wave, t0 = tile * 32, tok0 = b * SEQ + t0, t = t0 + r32, ktmax = grp * 8 + 7;
        bf16x8 qf[4]; ld_frags(qf, QK + (size_t)(tok0 + r32) * 2048 + h * 64 + 8 * hi);
        const bf16* Kb = QK + (size_t)(b * SEQ) * 2048 + 1024 + h * 64; const bf16* Vb = VT + (size_t)(h * 64) * T + b * SEQ;
        f32x16 o[2]; o[0] = f32x16{}; o[1] = f32x16{};
        float R = 0.f; bool done = false;
        if (tid == 0) flag[0] = 0u;
        const int k64max = grp * 4 + 3;
        kv_store(lds + KV_OFF + (k64max & 1) * KV_BUF, kv_issue(Kb, 2048, Vb, k64max * 64, tid), tid);
        __syncthreads();
        for (int k64 = k64max; k64 >= 0; --k64) {
            KVLD nx = {}; if (k64 > 0) nx = kv_issue(Kb, 2048, Vb, (k64 - 1) * 64, tid);
#pragma unroll 1
            for (int sub = 1; sub >= 0; --sub) { const int kt = 2 * k64 + sub;
                if (kt <= tile && !done) { KV x; kv_frags(x, lds + KV_OFF + (k64 & 1) * KV_BUF, sub, r32, hi);
                    sb_step(qk_tile(x.k, qf), t, kt * 32, hi, R, o, x.v);
                    if (__all(R < -150.f)) { done = true; if (lane == 0) atomicOr(flag, 1u << wave); } } }
            if (k64 > 0) kv_store(lds + KV_OFF + ((k64 - 1) & 1) * KV_BUF, nx, tid);
            __syncthreads();
            const bool alldone = (flag[0] == 0xffu);
            __syncthreads();
            if (alldone) break;
        }
        __syncthreads();
        write_o(O + (size_t)tok0 * 1024 + h * 64, 1024, o, 1.f, lane, stg);
    }
}

__device__ __forceinline__ void attn_dil(const bf16* __restrict__ QK, const bf16* __restrict__ VT, bf16* O, unsigned char* lds, int wg, int G, int wave, int lane, int tid, bf16* stg) {
    const int r32 = lane & 31, hi = lane >> 5;
    int bh, grp;
    for (int i = 0; grp_unit(i, wg, G, 16, bh, grp); ++i) {
        const int b = bh >> 3, h = bh & 7, tile = grp * 8 + wave, t0 = tile * 32, tok0 = b * SEQ + t0, t = t0 + r32, ktmax = grp * 8 + 7;
        f32x16 o[2]; o[0] = f32x16{}; o[1] = f32x16{};
        float m = -INFINITY, l = 0.f;
#pragma unroll 1
        for (int g = 0; g < 3; ++g) {
            const int dil = (g == 0) ? 1 : (g == 1 ? 4 : 16);
            const unsigned pat = ((g == 0) ? 0xffffffffu : (g == 1 ? 0x11111111u : 0x00010001u)) << (t & (dil - 1));
            bf16x8 qf[4]; ld_frags(qf, QK + (size_t)(tok0 + r32) * 3072 + g * 1024 + h * 64 + 8 * hi);
            const bf16* Kb = QK + (size_t)(b * SEQ) * 3072 + g * 1024 + 512 + h * 64; const bf16* Vb = VT + (size_t)(g * 512 + h * 64) * T + b * SEQ;
            const int lo = t - 128 * dil;
            int k640 = grp * 256 - 128 * dil; k640 = k640 < 0 ? 0 : (k640 >> 6);
            const int k64max = grp * 4 + 3;
            kv_store(lds + KV_OFF + (k640 & 1) * KV_BUF, kv_issue(Kb, 3072, Vb, k640 * 64, tid), tid);
            KVLD n1 = kv_issue(Kb, 3072, Vb, (k640 + 1 <= k64max ? k640 + 1 : k64max) * 64, tid);
            __syncthreads();
            for (int k64 = k640; k64 <= k64max; ++k64) {
                const KVLD n2 = kv_issue(Kb, 3072, Vb, (k64 + 2 <= k64max ? k64 + 2 : k64max) * 64, tid);
                { const int key0 = k64 * 64;
                  const unsigned am0 = pat & causal_bits(t, key0) & lower_bits(lo, key0), am1 = pat & causal_bits(t, key0 + 32) & lower_bits(lo, key0 + 32);
                  if (__ballot((am0 | am1) != 0u) != 0ull) { KV x0, x1; kv_frags(x0, lds + KV_OFF + (k64 & 1) * KV_BUF, 0, r32, hi); kv_frags(x1, lds + KV_OFF + (k64 & 1) * KV_BUF, 1, r32, hi);
                      sm_step64(qk_tile(x0.k, qf), qk_tile(x1.k, qf), am0, am1, hi, m, l, o, x0.v, x1.v); } }
                if (k64 < k64max) kv_store(lds + KV_OFF + ((k64 + 1) & 1) * KV_BUF, n1, tid);
                __syncthreads();
                n1 = n2;
            }
        }
        const float lt = l + __shfl_xor(l, 32);
        write_o(O + (size_t)tok0 * 512 + h * 64, 512, o, 1.f / lt, lane, stg);
    }
}

constexpr int LDC = 2816;
__device__ __forceinline__ unsigned mono_key(float f) { const unsigned u = __float_as_uint(f); return (u & 0x80000000u) ? ~u : (u | 0x80000000u); }
__device__ __forceinline__ f32x16 score_tile(const bf16* kip, const bf16x8* qis, const float* wis, int lane) {
    bf16x8 kf[4]; ld_frags(kf, kip);
    f32x16 sc = {};
    asm volatile("" : "+v"(lane));
#pragma unroll
    for (int h = 0; h < 8; ++h) { bf16x8 qf[4];
#pragma unroll
        for (int d0 = 0; d0 < 4; ++d0) qf[d0] = qis[(h * 4 + d0) * 64 + lane];
        const f32x16 s = qk_tile(kf, qf);
        const float w = wis[(lane & 31) * 8 + h];
#pragma unroll
        for (int r = 0; r < 16; ++r) sc[r] = __builtin_fmaf(w, fmaxf(s[r], 0.f), sc[r]); }
    return sc;
}
__device__ __forceinline__ void dsa_select(unsigned char* lds, const bf16* __restrict__ QK, unsigned* MASK, int wg, int G, int wave, int lane, int tid) {
    unsigned* hist = (unsigned*)lds;
    bf16x8* qis = (bf16x8*)(lds + 66048);
    unsigned* pref = (unsigned*)(lds + 99328); unsigned* need = pref + 32; unsigned* flag = pref + 64;
    unsigned* ccount = pref + 96; unsigned* ckey = pref + 128; unsigned* cpos = pref + 384;
    const int r32 = lane & 31, hi = lane >> 5;
    for (int j = wg; j < 512; j += G) {
        const int b = j >> 8, tile = (j < 256) ? j : 511 - j, t0 = tile * 32, tok0 = b * SEQ + t0, t = t0 + r32;
        float* wis = (float*)(pref + 640);
        const bf16* qrow = QK + (size_t)(tok0 + r32) * LDC;
#pragma unroll
        for (int d0 = 0; d0 < 4; ++d0) qis[(wave * 4 + d0) * 64 + lane] = *(const bf16x8*)(qrow + 2048 + wave * 64 + 16 * d0 + 8 * hi);
        if (wave == 0 && hi == 0) { const bf16x8 w8 = *(const bf16x8*)(qrow + 2624);
#pragma unroll
          for (int h = 0; h < 8; ++h) wis[r32 * 8 + h] = bf2f((unsigned short)w8[h]); }
        const bf16* kib = QK + (size_t)(b * SEQ + r32) * LDC + 2560 + 8 * hi;
        const int nkt = tile + 1;
        unsigned thrk = 0u; bool maskdone = false;
        if (tid < 32) { pref[tid] = 0u; need[tid] = 256u; }
        __syncthreads();
        if (t0 >= 256) {
            bool done = false;
#pragma unroll 1
            for (int lvl = 0; lvl < 4 && !done; ++lvl) {
                const int sh = (lvl == 0) ? 22 : (lvl == 1 ? 12 : (lvl == 2 ? 2 : 0)), nb = (lvl == 3) ? 2 : 10;
                const unsigned bmask = (1u << nb) - 1u;
                for (int i = tid; i < 32 * 513 / 4; i += NTHREADS) ((u32x4*)hist)[i] = (u32x4){0u, 0u, 0u, 0u};
                if (tid == 0) { flag[0] = 1u; flag[1] = 0u; }
                if (lvl == 2 && tid < 32) ccount[tid] = 0u;
                __syncthreads();
                const unsigned mypref = pref[r32];
#pragma unroll 1
                for (int kt = wave; kt < nkt; kt += 8) {
                    const f32x16 sc = score_tile(kib + (size_t)(kt * 32) * LDC, qis, wis, lane);
                    unsigned word = 0u;
#pragma unroll
                    for (int r = 0; r < 16; ++r) { const int key = kt * 32 + crow(r, hi); const unsigned k = mono_key(sc[r]);
                        const bool caus = key <= t; bool ok = caus; if (lvl > 0) ok = ok && ((k >> (sh + nb)) == mypref);
                        const unsigned bin = (k >> sh) & bmask;
                        if (ok) atomicAdd(&hist[r32 * 513 + (bin >> 1)], 1u << (16 * (bin & 1u)));
                        if (lvl == 2) {
                            if (caus && (k >> 12) > mypref) word |= 1u << crow(r, hi);
                            if (ok) { const unsigned slot = atomicAdd(&ccount[r32], 1u); if (slot < 8u) { ckey[r32 * 8 + slot] = k; cpos[r32 * 8 + slot] = (unsigned)key; } else flag[1] = 1u; } } }
                    if (lvl == 2) { word |= __shfl_xor(word, 32); if (hi == 0) MASK[(size_t)(tok0 + r32) * 256 + kt] = word; }
                }
                __syncthreads();
#pragma unroll 1
                for (int qq = 0; qq < 4; ++qq) { const int q = 4 * wave + qq; const unsigned nd = need[q];
                    const int base = q * 513 + 8 * (63 - lane);
                    unsigned tot = 0u;
#pragma unroll
                    for (int w = 0; w < 8; ++w) { const unsigned x = hist[base + w]; tot += (x & 0xffffu) + (x >> 16); }
                    unsigned incl = tot;
#pragma unroll
                    for (int off = 1; off < 64; off <<= 1) { const unsigned v = __shfl_up(incl, off); if (lane >= off) incl += v; }
                    const unsigned long long bal = __ballot(incl >= nd);
                    const int cl = bal ? (__ffsll((long long)bal) - 1) : 63;
                    if (lane == cl) { unsigned above = incl - tot, cb = 0u; int bsel = 16 * (63 - lane);
                        for (int jb = 15; jb >= 0; --jb) { const unsigned x = hist[base + (jb >> 1)]; const unsigned c = (jb & 1) ? (x >> 16) : (x & 0xffffu);
                            if (above + c >= nd) { bsel = 16 * (63 - lane) + jb; cb = c; break; } above += c; }
                        pref[q] = (pref[q] << nb) | (unsigned)bsel; need[q] = nd - above;
                        if (cb != nd - above) flag[0] = 0u; }
                }
                __syncthreads();
                done = (flag[0] != 0u) || (lvl == 3);
                if (done) thrk = pref[r32] << sh;
                if (done && lvl == 2 && flag[1] == 0u) {
                    if (tid < 256) { const int q = tid >> 3; const unsigned slot = tid & 7;
                        if (slot < ccount[q]) { const unsigned tk = pref[q] << sh, pz = cpos[q * 8 + slot];
                            if (ckey[q * 8 + slot] >= tk) atomicOr(&MASK[(size_t)(tok0 + q) * 256 + (pz >> 5)], 1u << (pz & 31u)); } }
                    maskdone = true; }
                __syncthreads();
            }
        }
        if (!maskdone)
#pragma unroll 1
        for (int kt = wave; kt < nkt; kt += 8) {
            const f32x16 sc = score_tile(kib + (size_t)(kt * 32) * LDC, qis, wis, lane);
            unsigned word = 0u;
#pragma unroll
            for (int r = 0; r < 16; ++r) { const int key = kt * 32 + crow(r, hi); const unsigned k = mono_key(sc[r]); const bool sel = (key <= t) && (k >= thrk); word |= (sel ? 1u : 0u) << crow(r, hi); }
            word |= __shfl_xor(word, 32);
            if (hi == 0) MASK[(size_t)(tok0 + r32) * 256 + kt] = word;
        }
        __syncthreads();
    }
}
__device__ __forceinline__ void attn_dsa(const bf16* __restrict__ QK, const bf16* __restrict__ VT, const unsigned* __restrict__ MASK, bf16* O, unsigned char* lds, int wg, int G, int wave, int lane, int tid, bf16* stg) {
    const int r32 = lane & 31, hi = lane >> 5;
    for (int i = 0; ; ++i) {
        int bh, grp;
        if (G == 256) { if (i >= 2) break; const int j = wg >> 3, s = j >> 2; bh = (wg & 7) * 4 + (j & 3); grp = (i == 0) ? s : 15 - s; }
        else { const int u = wg + i * G; if (u >= 512) break; bh = u >> 4; grp = u & 15; }
        const int b = bh >> 4, h = bh & 15, mt = grp * 8 + wave, tileA = 2 * mt, tok0 = b * SEQ + tileA * 32, k64max = grp * 8 + 7;
        bf16x8 qfA[4], qfB[4]; ld_frags(qfA, QK + (size_t)(tok0 + r32) * LDC + h * 64 + 8 * hi); ld_frags(qfB, QK + (size_t)(tok0 + 32 + r32) * LDC + h * 64 + 8 * hi);
        const bf16* Kb = QK + (size_t)(b * SEQ) * LDC + 1024 + h * 64; const bf16* Vb = VT + (size_t)(h * 64) * T + b * SEQ;
        f32x16 oA[2], oB[2]; oA[0] = f32x16{}; oA[1] = f32x16{}; oB[0] = f32x16{}; oB[1] = f32x16{};
        float mA = -INFINITY, lA = 0.f, mB = -INFINITY, lB = 0.f;
        const unsigned* mrowA = MASK + (size_t)(tok0 + r32) * 256; const unsigned* mrowB = mrowA + 32 * 256;
        kv_store(lds + KV_OFF, kv_issue(Kb, LDC, Vb, 0, tid), tid);
        KVLD n1 = kv_issue(Kb, LDC, Vb, (k64max >= 1 ? 1 : 0) * 64, tid);
        __syncthreads();
        for (int k64 = 0; k64 <= k64max; ++k64) {
            const int k2 = k64 + 2 <= k64max ? k64 + 2 : k64max;
            const KVLD n2 = kv_issue(Kb, LDC, Vb, k2 * 64, tid);
            if (k64 <= mt) {
                const u32x2 mwA = *(const u32x2*)(mrowA + 2 * k64), mwB = *(const u32x2*)(mrowB + 2 * k64);
                { KV x; kv_frags(x, lds + KV_OFF + (k64 & 1) * KV_BUF, 0, r32, hi);
                  sm_step(qk_tile(x.k, qfA), mwA.x, hi, mA, lA, oA, x.v); sm_step(qk_tile(x.k, qfB), mwB.x, hi, mB, lB, oB, x.v); }
                { KV x; kv_frags(x, lds + KV_OFF + (k64 & 1) * KV_BUF, 1, r32, hi);
                  if (k64 < mt) sm_step(qk_tile(x.k, qfA), mwA.y, hi, mA, lA, oA, x.v);
                  sm_step(qk_tile(x.k, qfB), mwB.y, hi, mB, lB, oB, x.v); } }
            if (k64 < k64max) kv_store(lds + KV_OFF + ((k64 + 1) & 1) * KV_BUF, n1, tid);
            __syncthreads();
            n1 = n2;
        }
        const float ltA = lA + __shfl_xor(lA, 32), ltB = lB + __shfl_xor(lB, 32);
        write_o(O + (size_t)tok0 * 1024 + h * 64, 1024, oA, 1.f / ltA, lane, stg);
        write_o(O + (size_t)(tok0 + 32) * 1024 + h * 64, 1024, oB, 1.f / ltB, lane, stg);
    }
}

__device__ __forceinline__ void moba_kmean(const bf16* __restrict__ QK, float* KM, int gw, int NGW, int lane) {
    for (int u = gw; u < 1024; u += NGW) { const int b = u >> 9, h = (u >> 5) & 15, blk = u & 31;
        const bf16* kp = QK + (size_t)(b * SEQ + blk * 256) * 2048 + 1024 + h * 64 + lane;
        float s = 0.f;
        for (int jk = 0; jk < 256; ++jk) s += bf2f(kp[(size_t)jk * 2048]);
        KM[u * 64 + lane] = s * (1.f / 256.f); }
}
__device__ __forceinline__ unsigned moba_gate(const bf16* qrow, const float* km, int cur) {
    unsigned sel = 0u;
    if (cur > 0) {
        float qv[64];
#pragma unroll
        for (int c = 0; c < 8; ++c) { const bf16x8 q8 = *(const bf16x8*)(qrow + 8 * c);
#pragma unroll
            for (int e = 0; e < 8; ++e) qv[8 * c + e] = bf2f((unsigned short)q8[e]); }
        float v0 = -INFINITY, v1 = -INFINITY, v2 = -INFINITY; int i0 = -1, i1 = -1, i2 = -1;
#pragma unroll 1
        for (int blk = 0; blk < cur; ++blk) { const float* kr = km + blk * 64; float g0 = 0.f, g1 = 0.f;
#pragma unroll
            for (int dd = 0; dd < 64; dd += 2) { g0 = __builtin_fmaf(qv[dd], kr[dd], g0); g1 = __builtin_fmaf(qv[dd + 1], kr[dd + 1], g1); }
            const float g = g0 + g1;
            if (g > v2) { if (g > v1) { v2 = v1; i2 = i1; if (g > v0) { v1 = v0; i1 = i0; v0 = g; i0 = blk; } else { v1 = g; i1 = blk; } } else { v2 = g; i2 = blk; } } }
        if (i0 >= 0) sel |= 1u << i0; if (i1 >= 0) sel |= 1u << i1; if (i2 >= 0) sel |= 1u << i2;
    }
    return sel;
}
__device__ __forceinline__ void attn_moba(const bf16* __restrict__ QK, const bf16* __restrict__ VT, const float* __restrict__ KM, bf16* O, unsigned char* lds, int wg, int G, int wave, int lane, int tid, bf16* stg) {
    const int r32 = lane & 31, hi = lane >> 5;
    unsigned* flag = (unsigned*)(lds + KV_OFF + 2 * KV_BUF);
    for (int i = 0; ; ++i) {
        int bh, grp;
        if (G == 256) { if (i >= 2) break; const int j = wg >> 3, s = j >> 2; bh = (wg & 7) * 4 + (j & 3); grp = (i == 0) ? s : 15 - s; }
        else { const int u = wg + i * G; if (u >= 512) break; bh = u >> 4; grp = u & 15; }
        const int b = bh >> 4, h = bh & 15, mt = grp * 8 + wave, tileA = 2 * mt, t0 = tileA * 32, tok0 = b * SEQ + t0, tA = t0 + r32, tB = tA + 32;
        const int cur = mt >> 2, own0 = grp * 2, k64max = grp * 8 + 7;
        const bf16* qrowA = QK + (size_t)(tok0 + r32) * 2048 + h * 64; const bf16* qrowB = qrowA + (size_t)32 * 2048;
        if (tid == 0) flag[0] = 0u;
        int zoff = 0; asm volatile("" : "+v"(zoff));
        const float* km = KM + (size_t)(bh * 32) * 64 + zoff;
        const unsigned selA = moba_gate(qrowA, km, cur), selB = moba_gate(qrowB, km, cur);
        __syncthreads();
        { unsigned ws = 0u;
#pragma unroll 1
          for (int blk = 0; blk < cur; ++blk) if (__ballot(((selA | selB) >> blk) & 1u) != 0ull) ws |= 1u << blk;
          if (lane == 0 && ws) atomicOr(flag, ws); }
        __syncthreads();
        const unsigned wsel = flag[0];
        bf16x8 qfA[4], qfB[4]; ld_frags(qfA, qrowA + 8 * hi); ld_frags(qfB, qrowB + 8 * hi);
        const bf16* Kb = QK + (size_t)(b * SEQ) * 2048 + 1024 + h * 64; const bf16* Vb = VT + (size_t)(h * 64) * T + b * SEQ;
        f32x16 oA[2], oB[2]; oA[0] = f32x16{}; oA[1] = f32x16{}; oB[0] = f32x16{}; oB[1] = f32x16{};
        float mA = -INFINITY, lA = 0.f, mB = -INFINITY, lB = 0.f;
#define MOBA_NXT(k, out) do { int n_ = (k) + 1; while (n_ <= k64max && (n_ >> 2) < own0 && !((wsel >> (n_ >> 2)) & 1u)) n_ = ((n_ >> 2) + 1) << 2; out = n_; } while (0)
        int k64; MOBA_NXT(-1, k64);
        int kn; MOBA_NXT(k64, kn);
        int par = 0;
        kv_store(lds + KV_OFF, kv_issue(Kb, 2048, Vb, k64 * 64, tid), tid);
        KVLD n1 = kv_issue(Kb, 2048, Vb, (kn <= k64max ? kn : k64) * 64, tid);
        __syncthreads();
        while (k64 <= k64max) {
            int knn = kn; if (kn <= k64max) MOBA_NXT(kn, knn);
            const KVLD n2 = kv_issue(Kb, 2048, Vb, (knn <= k64max ? knn : k64) * 64, tid);
            const int blk = k64 >> 2;
            const unsigned fullA = ((selA >> blk) & 1u) ? 0xffffffffu : 0u, fullB = ((selB >> blk) & 1u) ? 0xffffffffu : 0u;
#pragma unroll 1
            for (int sub = 0; sub < 2; ++sub) { const int key0 = k64 * 64 + sub * 32;
                const unsigned amA = (blk < cur) ? fullA : causal_bits(tA, key0), amB = (blk < cur) ? fullB : causal_bits(tB, key0);
                if (__ballot((amA | amB) != 0u) != 0ull) { KV x; kv_frags(x, lds + KV_OFF + par * KV_BUF, sub, r32, hi);
                    sm_step(qk_tile(x.k, qfA), amA, hi, mA, lA, oA, x.v); sm_step(qk_tile(x.k, qfB), amB, hi, mB, lB, oB, x.v); } }
            if (kn <= k64max) kv_store(lds + KV_OFF + (par ^ 1) * KV_BUF, n1, tid);
            __syncthreads();
            par ^= 1; k64 = kn; kn = knn; n1 = n2;
        }
#undef MOBA_NXT
        const float ltA = lA + __shfl_xor(lA, 32), ltB = lB + __shfl_xor(lB, 32);
        write_o(O + (size_t)tok0 * 1024 + h * 64, 1024, oA, 1.f / ltA, lane, stg);
        write_o(O + (size_t)(tok0 + 32) * 1024 + h * 64, 1024, oB, 1.f / ltB, lane, stg);
    }
}

#define XB_TMO      128
#define XB_XCNT(j)  (256  + 64 * (j))
#define XB_XSUB(j)  (1280 + 64 * (j))
#define XB_XGEN(j)  (2304 + 64 * (j))
#define XB_TOP      3328
#define XB_TOPGEN   3392
#define XCD_BAR_WORDS 3456
#define XB_SPIN_CAP (1u << 18)

__device__ __forceinline__ unsigned xb_ld(unsigned* p)              { return __hip_atomic_load(p, __ATOMIC_RELAXED, __HIP_MEMORY_SCOPE_AGENT); }
__device__ __forceinline__ unsigned xb_add(unsigned* p, unsigned v) { return __hip_atomic_fetch_add(p, v, __ATOMIC_RELAXED, __HIP_MEMORY_SCOPE_AGENT); }
__device__ __forceinline__ unsigned xb_xcc_id() { return (unsigned)__builtin_amdgcn_s_getreg((3 << 11) | 20) & 0xFu; }
#define XB_SPIN(cond, bar) do { unsigned _sp = 0; while (cond) { __builtin_amdgcn_s_sleep(1); \
    if ((++_sp & 255u) == 0u) { if (xb_ld(&(bar)[XB_TMO])) break; if (_sp > XB_SPIN_CAP) { atomicAdd(&(bar)[XB_TMO], 1u); break; } } } } while (0)

struct XcdBarrier {
    unsigned* bar; unsigned x;
    volatile LAS unsigned* st;
};

__device__ __forceinline__ XcdBarrier xcd_barrier_post(unsigned* bar, volatile LAS unsigned* st) {
    XcdBarrier b; b.bar = bar; b.x = xb_xcc_id(); b.st = st;
    if (threadIdx.x == 0) (void)xb_add(&bar[XB_XCNT(b.x)], 1u);
    return b;
}
__device__ __forceinline__ void xcd_barrier_complete(unsigned* bar, unsigned x, unsigned& nloc, unsigned& nx) {
    const unsigned G = gridDim.x * gridDim.y * gridDim.z;
    unsigned sum, cnt, mine, sp = 0u;
    for (;;) {
        sum = 0u; cnt = 0u; mine = 0u;
#pragma unroll
        for (unsigned j = 0; j < 16; ++j) { const unsigned c = xb_ld(&bar[XB_XCNT(j)]); sum += c; cnt += (c > 0u) ? 1u : 0u; mine = (j == x) ? c : mine; }
        if (sum == G) break;
        __builtin_amdgcn_s_sleep(1);
        if ((++sp & 255u) == 0u) { if (xb_ld(&bar[XB_TMO])) break; if (sp > XB_SPIN_CAP) { atomicAdd(&bar[XB_TMO], 1u); break; } }
    }
    nloc = mine > 0u ? mine : 1u; nx = cnt > 0u ? cnt : 1u;
}

__device__ __forceinline__ void xcd_barrier(const XcdBarrier& b) {
    asm volatile("s_waitcnt vmcnt(0)" ::: "memory");
    __syncthreads();
    if (threadIdx.x == 0) {
        unsigned* bar = b.bar;
        __builtin_amdgcn_s_waitcnt(0);
        unsigned nloc = b.st[0], nx = b.st[1];
        if (nloc == 0u) { xcd_barrier_complete(bar, b.x, nloc, nx); b.st[0] = nloc; b.st[1] = nx; }
        const unsigned old = xb_add(&bar[XB_XSUB(b.x)], 1u);
        const unsigned gen = old / nloc;
        if (old + 1u == (gen + 1u) * nloc) {
            __builtin_amdgcn_fence(__ATOMIC_RELEASE, "agent");
            asm volatile("s_waitcnt vmcnt(0)" ::: "memory");
            const unsigned og = xb_add(&bar[XB_TOP], 1u);
            const unsigned tg = og / nx;
            if (og + 1u == (tg + 1u) * nx) xb_add(&bar[XB_TOPGEN], 1u);
            else XB_SPIN(xb_ld(&bar[XB_TOPGEN]) == tg, bar);
            __builtin_amdgcn_fence(__ATOMIC_ACQUIRE, "agent");
            xb_add(&bar[XB_XGEN(b.x)], 1u);
            asm volatile("s_waitcnt vmcnt(0)" ::: "memory");
        } else {
            XB_SPIN(xb_ld(&bar[XB_XGEN(b.x)]) == gen, bar);
            __builtin_amdgcn_fence(__ATOMIC_ACQUIRE, "agent");
            asm volatile("s_waitcnt vmcnt(0)" ::: "memory");
        }
    }
    __syncthreads();
}

#ifndef EN
#define EN 0xffff
#endif
#ifndef PROBE_ST
#define PROBE_ST -1
#endif
constexpr int NSTEP = 11 + (PROBE_ST >= 0 ? 1 : 0), NPHASE = 4 * NSTEP;
__global__ void __launch_bounds__(NTHREADS, 2) mega(Args a) {
    extern __shared__ __attribute__((aligned(16))) unsigned char lds[];
    cg::grid_group grid = cg::this_grid();
    typedef const __attribute__((address_space(4))) Args* kargp;
    unsigned long long apv = (unsigned long long)__builtin_amdgcn_kernarg_segment_ptr();
    PG8_LAS unsigned char* lds3 = (PG8_LAS unsigned char*)lds;
    const int ph_lo = ((kargp)apv)->lo, ph_hi = ((kargp)apv)->hi;
    if (threadIdx.x < 2) ((volatile LAS unsigned*)(lds3 + 143360))[threadIdx.x] = 0u;
    __syncthreads();
    XcdBarrier xbar = xcd_barrier_post((unsigned*)(((kargp)apv)->ws) + 1024, (volatile LAS unsigned*)(lds3 + 143360));
    if (ph_lo < 0) grid.sync();
    for (int ph = ph_lo; ph < ph_hi; ++ph) {
        asm volatile("" : "+s"(apv));
        const kargp ap = (kargp)apv;
        int tidv = threadIdx.x; asm volatile("" : "+v"(tidv));
        const int tid = tidv, lane = tid & 63, wave = __builtin_amdgcn_readfirstlane(tid >> 6);
        int wgv = blockIdx.x; asm volatile("" : "+s"(wgv));
        const int G = gridDim.x, wg = wgv, gw = wg * 8 + wave, NGW = G * 8;
#define a (*ap)
        unsigned char* ws = a.ws;
        float* cs = (float*)(ws + WS_ROPE); float* sn = cs + T * 8;
        float* KM = (float*)(ws + WS_KMEAN);
        bf16* Wqk = (bf16*)(ws + WS_W + W_QK); bf16* Wv = (bf16*)(ws + WS_W + W_V); bf16* Wo = (bf16*)(ws + WS_W + W_OUT);
        bf16* Wfi = (bf16*)(ws + WS_W + W_FI); bf16* Wfo = (bf16*)(ws + WS_W + W_FO); bf16* Wg = (bf16*)(ws + WS_W + W_G); bf16* Wp = (bf16*)(ws + WS_W + W_P);
        bf16* U = (bf16*)(ws + WS_U); bf16* QK = (bf16*)(ws + WS_QK); bf16* VT = (bf16*)(ws + WS_VT); bf16* HID = (bf16*)(ws + WS_HID);
        float* Y = (float*)(ws + WS_Y); unsigned* MASK = (unsigned*)(ws + WS_Y); bf16* PB = (bf16*)(ws + WS_PB);
        float* H = a.out;
        float* scr = (float*)(lds + wave * 16384);
        bf16* stg = (bf16*)(lds + wave * 4608);
        const int L0 = ph / NSTEP, L = (L0 + a.lshift) & 3, sk = ph % NSTEP, st = (PROBE_ST >= 0 && sk > PROBE_ST) ? sk - 1 : sk;
        const int nqk = (L == 1) ? 3072 : (L == 2 ? 2816 : 2048), nv = (L == 1) ? 1536 : 1024, kout = (L == 1) ? 512 : 1024;
        bool sync_after = true;
        if (st == 0) {
            if (L0 == 0) {
                for (int idx = gw * 64 + lane; idx < T * 8; idx += NGW * 64) { const int tk = idx >> 3, i = idx & 7;
                    const float inv = (i == 0) ? 1.0f : (i == 1) ? 0.1939227432012558f : (i == 2) ? 0.03760603070259094f : (i == 3) ? 0.007292664609849453f : (i == 4) ? 0.0014142135623842478f : (i == 5) ? 0.00027424818836152554f : (i == 6) ? 5.318296098266728e-05f : 1.0313386155758053e-05f;
                    const float ang = (float)a.pos[tk] * inv;
                    double rev = (double)ang * 0.15915494309189535; rev -= rint(rev);
                    const float rf = (float)rev;
                    cs[idx] = __builtin_amdgcn_cosf(rf); sn[idx] = __builtin_amdgcn_sinf(rf); }
            }
            int troff = 0;
            const float* win = a.w_in[L];
            if (L == 0 || L == 3) { tr_seg(win, 3072, 1024, 0, 2048, 2048, Wqk, 0, scr, gw, NGW, lane, troff); tr_seg(win, 3072, 1024, 2048, 1024, 1024, Wv, 0, scr, gw, NGW, lane, troff); }
            else if (L == 1) { for (int g = 0; g < 3; ++g) { tr_seg(win, 4608, 1024, g * 1536, 1024, 1024, Wqk, g * 1024, scr, gw, NGW, lane, troff); tr_seg(win, 4608, 1024, g * 1536 + 1024, 512, 512, Wv, g * 512, scr, gw, NGW, lane, troff); } }
            else { tr_seg(win, 3656, 1024, 0, 2048, 2048, Wqk, 0, scr, gw, NGW, lane, troff); tr_seg(win, 3656, 1024, 2048, 1024, 1024, Wv, 0, scr, gw, NGW, lane, troff); tr_seg(win, 3656, 1024, 3072, 584, 768, Wqk, 2048, scr, gw, NGW, lane, troff); }
            tr_seg(a.w_out[L], 1024, kout, 0, 1024, 1024, Wo, 0, scr, gw, NGW, lane, troff);
            tr_seg(a.w_ff_in + (size_t)L * DM * FF, FF, DM, 0, FF, FF, Wfi, 0, scr, gw, NGW, lane, troff);
            tr_seg(a.w_ff_out + (size_t)L * FF * DM, DM, FF, 0, DM, DM, Wfo, 0, scr, gw, NGW, lane, troff);
            tr_seg(a.w_ple_gate + (size_t)L * DM * DM, DM, DM, 0, DM, DM, Wg, 0, scr, gw, NGW, lane, troff);
            tr_seg(a.w_ple + (size_t)L * PLE * DM, DM, PLE, 0, DM, DM, Wp, 0, scr, gw, NGW, lane, troff);
            const float* hin = (L0 == 0) ? a.x : H;
            for (int r = gw; r < T; r += NGW) norm1_row(hin + (size_t)r * DM, a.g_mix_pre + L * DM, U + (size_t)r * DM, lane);
        } else if (st == 1) {
            { pg8::Gemm g{U, Wqk, T, nqk, DM}; pg8::StaticOrder S; S.init(T, nqk, G, wg);
              EpiQK E{QK, nqk, cs, sn, (L == 0) ? 0 : (L == 1 ? 48 : (L == 2 ? 41 : 32))};
              pg8::gemm_phase<EpiQK, pg8::StaticOrder, true, true>(lds3, g, S, E); }
            { pg8::Gemm g{Wv, U, nv, T, DM}; pg8::StaticOrder S; S.init(nv, T, G, wg);
              EpiB16<0> E{VT, T};
              pg8::gemm_phase<EpiB16<0>, pg8::StaticOrder, true, true>(lds3, g, S, E); }
        } else if (st == 2) {
            if (L == 2 && (EN & 1)) dsa_select(lds, QK, MASK, wg, G, wave, lane, tid);
            else if (L == 3 && (EN & 2)) moba_kmean(QK, KM, gw, NGW, lane);
            else sync_after = false;
        } else if (st == 3) {
            if (L == 0 && (EN & 4)) attn_sb(QK, VT, U, lds, wg, G, wave, lane, tid, stg);
            else if (L == 1 && (EN & 8)) attn_dil(QK, VT, U, lds, wg, G, wave, lane, tid, stg);
            else if (L == 2 && (EN & 16)) attn_dsa(QK, VT, MASK, U, lds, wg, G, wave, lane, tid, stg);
            else if (EN & 32) attn_moba(QK, VT, KM, U, lds, wg, G, wave, lane, tid, stg);
        } else if (st == 4 || st == 7 || st == 9) {
            const bf16* A = (st == 4) ? U : (st == 7 ? HID : PB); const bf16* B = (st == 4) ? Wo : (st == 7 ? Wfo : Wp); const int K = (st == 4) ? kout : (st == 7 ? FF : PLE);
            pg8::Gemm g{A, B, T, DM, K}; pg8::StaticOrder S; S.init(T, DM, G, wg);
            EpiB16<0> E{(bf16*)Y, DM};
            pg8::gemm_phase<EpiB16<0>, pg8::StaticOrder, true, true>(lds3, g, S, E);
            if (st == 9) sync_after = false;
        } else if (st == 5 || st == 8) {
            const float* gpost = (st == 5 ? a.g_mix_post : a.g_ffn_post) + L * DM; const float* gnext = (st == 5 ? a.g_ffn_pre : a.g_ple) + L * DM;
            const float* base = (st == 5 && L0 == 0) ? a.x : H;
            for (int r = gw; r < T; r += NGW) {
                norm2_row(base + (size_t)r * DM, (const bf16*)Y + (size_t)r * DM, gpost, gnext, H + (size_t)r * DM, U + (size_t)r * DM, lane);
                if (st == 8) { const f32x4 pv = *(const f32x4*)(a.p + ((size_t)L * T + r) * PLE + lane * 4); u32x2 w; w.x = pk2(pv[0], pv[1]); w.y = pk2(pv[2], pv[3]); *(u32x2*)(PB + (size_t)r * PLE + lane * 4) = w; }
            }
        } else if (st == 6) {
            pg8::Gemm g{U, Wfi, T, FF, DM}; pg8::StaticOrder S; S.init(T, FF, G, wg);
            EpiB16<2> E{HID, FF};
            pg8::gemm_phase<EpiB16<2>, pg8::StaticOrder, true, true>(lds3, g, S, E);
        } else {
            pg8::Gemm g{U, Wg, T, DM, DM}; pg8::StaticOrder S; S.init(T, DM, G, wg);
            EpiGate E{H, (const bf16*)Y, DM};
            pg8::gemm_phase<EpiGate, pg8::StaticOrder, true, true>(lds3, g, S, E);
        }
        if (sync_after && ph + 1 < ph_hi) {
            xcd_barrier(xbar);
        }
#undef a
    }
    {
        const kargp ap = (kargp)apv; const int dump = ap->dump;
        if (dump) {
            asm volatile("s_waitcnt vmcnt(0) lgkmcnt(0)" ::: "memory"); __builtin_amdgcn_fence(__ATOMIC_RELEASE, "agent"); asm volatile("s_waitcnt vmcnt(0) lgkmcnt(0)" ::: "memory");
            grid.sync();
            __builtin_amdgcn_fence(__ATOMIC_ACQUIRE, "agent"); asm volatile("s_waitcnt vmcnt(0) lgkmcnt(0)" ::: "memory");
            unsigned char* ws = ap->ws; float* outp = ap->out;
            const size_t n = (size_t)T * DM;
            for (size_t i = (size_t)blockIdx.x * NTHREADS + threadIdx.x; i < n; i += (size_t)gridDim.x * NTHREADS) {
                float v;
                if (dump == 1) v = bf2f(((const bf16*)(ws + WS_U))[i]);
                else if (dump == 2) v = bf2f(((const bf16*)(ws + WS_QK))[(i >> 10) * 2048 + (i & 1023)]);
                else if (dump == 3) v = bf2f(((const bf16*)(ws + WS_QK))[(i >> 10) * 2048 + 1024 + (i & 1023)]);
                else if (dump == 4) v = bf2f(((const bf16*)(ws + WS_VT))[i]);
                else v = ((const float*)(ws + WS_Y))[i];
                outp[i] = v;
            }
        }
    }
}

extern "C" void kernel_launch(void* const* d_in, const int* in_sizes, int n_in, void* d_out, int out_size, void* d_ws, size_t ws_size, hipStream_t stream) {
    static int grid = 0;
    if (grid == 0) {
        if (n_in != 20 || ws_size < WS_END) { fprintf(stderr, "kernel_launch: unexpected n_in %d or ws_size %zu\n", n_in, ws_size); grid = -1; return; }
        int dev = 0, cus = 0, per_cu = 0;
        hipGetDevice(&dev); hipDeviceGetAttribute(&cus, hipDeviceAttributeMultiprocessorCount, dev);
        hipFuncSetAttribute((const void*)mega, hipFuncAttributeMaxDynamicSharedMemorySize, LDS_BYTES);
        hipOccupancyMaxActiveBlocksPerMultiprocessor(&per_cu, (const void*)mega, NTHREADS, LDS_BYTES);
        if (per_cu < 1) { fprintf(stderr, "kernel_launch: occupancy query says %d blocks per CU\n", per_cu); per_cu = 1; }
        (void)hipGetLastError();
        grid = cus * 1;
    }
    if (grid < 0) return;
    if (hipMemsetAsync(d_ws, 0, 65536, stream) != hipSuccess) { fprintf(stderr, "kernel_launch: hipMemsetAsync of the barrier words failed\n"); return; }
    Args a{};
    a.x = (const float*)d_in[0]; a.p = (const float*)d_in[1]; a.pos = (const int*)d_in[2];
    for (int i = 0; i < 4; ++i) { a.w_in[i] = (const float*)d_in[3 + 2 * i]; a.w_out[i] = (const float*)d_in[4 + 2 * i]; }
    a.g_mix_pre = (const float*)d_in[11]; a.g_mix_post = (const float*)d_in[12]; a.g_ffn_pre = (const float*)d_in[13]; a.g_ffn_post = (const float*)d_in[14];
    a.w_ff_in = (const float*)d_in[15]; a.w_ff_out = (const float*)d_in[16]; a.g_ple = (const float*)d_in[17]; a.w_ple_gate = (const float*)d_in[18]; a.w_ple = (const float*)d_in[19];
    a.out = (float*)d_out; a.ws = (unsigned char*)d_ws; a.lo = 0; a.hi = NPHASE; a.dump = 0; a.lshift = 0;
    void* args[] = {&a};
    hipError_t e = hipLaunchCooperativeKernel((const void*)mega, dim3(grid), dim3(NTHREADS), args, LDS_BYTES, stream);
    if (e != hipSuccess) fprintf(stderr, "kernel_launch: cooperative launch failed: %s (grid %d)\n", hipGetErrorString(e), grid);
}
```
